# Optimizing an MI355X kernel written in HIP

```python
import jax, jax.numpy as jnp
from jax import lax
import numpy as np

D_MODEL = 1024
BATCH = 4
SEQ = 8192
DEPTH = 4

N_MIXERS = 2
EPS = 1e-6

CHUNK = 128
A_WIDTH = 2 * D_MODEL
A_GROUPS = 8
A_GROUP_DIM = A_WIDTH // A_GROUPS

B_WINDOWS = (2, 4, 8, 16)
B_GROUPS = len(B_WINDOWS)
B_WIDTH = D_MODEL
B_GROUP_DIM = B_WIDTH // B_GROUPS

D_FF = ((8 * D_MODEL + 3 * 256 - 1) // (3 * 256)) * 256

N_A_LAYERS = (DEPTH + 1) // 2
N_B_LAYERS = DEPTH // 2

kernel_name = 'hybrid_gmlp_pool_swiglu_trunk'


def rmsnorm(x, g):
    xf = x.astype(jnp.float32)
    y = xf * lax.rsqrt(jnp.mean(xf * xf, axis=-1, keepdims=True) + EPS)
    return (y * g.astype(jnp.float32)).astype(x.dtype)


def layernorm(x, g, b):
    xf = x.astype(jnp.float32)
    mu = jnp.mean(xf, axis=-1, keepdims=True)
    xc = xf - mu
    var = jnp.mean(xc * xc, axis=-1, keepdims=True)
    y = xc * lax.rsqrt(var + EPS) * g.astype(jnp.float32) + b.astype(jnp.float32)
    return y.astype(x.dtype)


def mixer_a(h, w_in, ln_g, ln_b, w_s, b_s, w_out):
    bsz, s, _ = h.shape
    z = jax.nn.gelu(h @ w_in, approximate=False)
    u, v = jnp.split(z, 2, axis=-1)
    v = layernorm(v, ln_g, ln_b)
    n_chunks = s // CHUNK
    v = v.reshape(bsz, n_chunks, CHUNK, A_GROUPS, A_GROUP_DIM)
    u = u.reshape(bsz, n_chunks, CHUNK, A_GROUPS, A_GROUP_DIM)
    causal = jnp.tril(jnp.ones((CHUNK, CHUNK), dtype=bool))
    w = jnp.where(causal[None], w_s, jnp.zeros_like(w_s))
    sv = jnp.einsum('gts,bnsgd->bntgd', w, v)
    sv = sv + jnp.transpose(b_s)[None, None, :, :, None]
    gated = (u * sv).reshape(bsz, s, A_WIDTH)
    return gated @ w_out


def mixer_b(h, w_in, w_grp, scale, w_out):
    bsz, s, _ = h.shape
    p = h @ w_in
    pf = p.astype(jnp.float32)
    cs = jnp.cumsum(pf, axis=1)
    cs0 = jnp.concatenate([jnp.zeros((bsz, 1, B_WIDTH), jnp.float32), cs], axis=1)
    t = jnp.arange(s)
    pooled = []
    for g, win in enumerate(B_WINDOWS):
        lo, hi = g * B_GROUP_DIM, (g + 1) * B_GROUP_DIM
        c = cs0[..., lo:hi]
        c_pad = jnp.concatenate([jnp.zeros((bsz, win - 1, B_GROUP_DIM), jnp.float32), c], axis=1)
        total = c[:, 1:] - c_pad[:, :s]
        count = jnp.minimum(t + 1, win).astype(jnp.float32)
        pooled.append(total / count[None, :, None] - pf[..., lo:hi])
    pooled = jnp.stack(pooled, axis=2)
    mixed = jnp.einsum('bsgd,gde->bsge', pooled, w_grp.astype(jnp.float32))
    mixed = mixed.reshape(bsz, s, B_WIDTH) * scale.astype(jnp.float32)
    return mixed.astype(h.dtype) @ w_out


def swiglu(h, w_gate, w_up, w_down):
    return (jax.nn.silu(h @ w_gate) * (h @ w_up)) @ w_down


def setup_inputs(seed: int = 0) -> dict:
    key = jax.random.key(seed)
    ks = jax.random.split(key, 20)
    f32 = jnp.float32
    d = D_MODEL
    x = jax.random.normal(ks[0], (BATCH, SEQ, d), f32)
    a_w_in = jax.random.normal(ks[1], (N_A_LAYERS, d, 2 * A_WIDTH), f32) * d ** -0.5
    a_ln_g = 1.0 + 0.02 * jax.random.normal(ks[2], (N_A_LAYERS, A_WIDTH), f32)
    a_ln_b = 0.02 * jax.random.normal(ks[3], (N_A_LAYERS, A_WIDTH), f32)
    a_w_s = jnp.tril(jax.random.normal(ks[4], (N_A_LAYERS, A_GROUPS, CHUNK, CHUNK), f32) * CHUNK ** -0.5)
    a_b_s = 1.0 + 0.1 * jax.random.normal(ks[5], (N_A_LAYERS, A_GROUPS, CHUNK), f32)
    a_w_out = jax.random.normal(ks[6], (N_A_LAYERS, A_WIDTH, d), f32) * A_WIDTH ** -0.5
    b_w_in = jax.random.normal(ks[7], (N_B_LAYERS, d, B_WIDTH), f32) * d ** -0.5
    b_w_grp = jax.random.normal(ks[8], (N_B_LAYERS, B_GROUPS, B_GROUP_DIM, B_GROUP_DIM), f32) * B_GROUP_DIM ** -0.5
    b_scale = 1.0 + 0.1 * jax.random.normal(ks[9], (N_B_LAYERS, B_WIDTH), f32)
    b_w_out = jax.random.normal(ks[10], (N_B_LAYERS, B_WIDTH, d), f32) * B_WIDTH ** -0.5
    mix_pre_g = 1.0 + 0.02 * jax.random.normal(ks[11], (DEPTH, d), f32)
    mix_post_g = 1.0 + 0.02 * jax.random.normal(ks[12], (DEPTH, d), f32)
    ffn_pre_g = 1.0 + 0.02 * jax.random.normal(ks[13], (DEPTH, d), f32)
    ffn_post_g = 1.0 + 0.02 * jax.random.normal(ks[14], (DEPTH, d), f32)
    ffn_w_gate = jax.random.normal(ks[15], (DEPTH, d, D_FF), f32) * d ** -0.5
    ffn_w_up = jax.random.normal(ks[16], (DEPTH, d, D_FF), f32) * d ** -0.5
    ffn_w_down = jax.random.normal(ks[17], (DEPTH, D_FF, d), f32) * D_FF ** -0.5
    return {'x': x, 'a_w_in': a_w_in, 'a_ln_g': a_ln_g, 'a_ln_b': a_ln_b,
            'a_w_s': a_w_s, 'a_b_s': a_b_s, 'a_w_out': a_w_out,
            'b_w_in': b_w_in, 'b_w_grp': b_w_grp, 'b_scale': b_scale, 'b_w_out': b_w_out,
            'mix_pre_g': mix_pre_g, 'mix_post_g': mix_post_g,
            'ffn_pre_g': ffn_pre_g, 'ffn_post_g': ffn_post_g,
            'ffn_w_gate': ffn_w_gate, 'ffn_w_up': ffn_w_up, 'ffn_w_down': ffn_w_down}


def reference(x, a_w_in, a_ln_g, a_ln_b, a_w_s, a_b_s, a_w_out,
              b_w_in, b_w_grp, b_scale, b_w_out,
              mix_pre_g, mix_post_g, ffn_pre_g, ffn_post_g,
              ffn_w_gate, ffn_w_up, ffn_w_down):
    for i in range(DEPTH):
        j = i // N_MIXERS
        h = rmsnorm(x, mix_pre_g[i])
        if i % N_MIXERS == 0:
            m = mixer_a(h, a_w_in[j], a_ln_g[j], a_ln_b[j], a_w_s[j], a_b_s[j], a_w_out[j])
        else:
            m = mixer_b(h, b_w_in[j], b_w_grp[j], b_scale[j], b_w_out[j])
        x = x + rmsnorm(m, mix_post_g[i])
        h = rmsnorm(x, ffn_pre_g[i])
        f = swiglu(h, ffn_w_gate[i], ffn_w_up[i], ffn_w_down[i])
        x = x + rmsnorm(f, ffn_post_g[i])
    return x
```

```cpp
#include <hip/hip_runtime.h>
#include <hip/hip_cooperative_groups.h>
#include <cstdio>
namespace cg = cooperative_groups;

#ifndef N_LAUNCH_MODE
#define N_LAUNCH_MODE 0
#endif

#ifndef PHMASK
#define PHMASK 0xFFFF
#endif
#define LAS __attribute__((address_space(3)))
typedef unsigned short bf16_t;
typedef short bf16x8 __attribute__((ext_vector_type(8)));
typedef float f32x4 __attribute__((ext_vector_type(4)));
typedef float f32x2 __attribute__((ext_vector_type(2)));
typedef unsigned u32x4 __attribute__((ext_vector_type(4)));
typedef unsigned u32x2 __attribute__((ext_vector_type(2)));

constexpr int MTOK = 32768, DM = 1024, SEQ = 8192, AW = 2048, DFF = 2816, DEPTH = 4;
constexpr float EPS = 1e-6f;
constexpr int BM = 256, BK = 64, HALF = 128, HTB = HALF * BK * 2, STAGE_BYTES = 8 * HTB, NXCD = 8, WGM = 8;
constexpr int LDS_BYTES = STAGE_BYTES;
constexpr int NTHREADS = 512;

constexpr size_t MiB = 1024 * 1024;
constexpr size_t WS_AWIN = 0;
constexpr size_t WS_AWOUT = 16 * MiB;
constexpr size_t WS_AWS = 24 * MiB;
constexpr size_t WS_BWIN = 26 * MiB;
constexpr size_t WS_BWGRP = 30 * MiB;
constexpr size_t WS_BWOUT = 31 * MiB;
constexpr size_t WS_FGU = 35 * MiB;
constexpr size_t WS_FDN = 79 * MiB;
constexpr size_t WS_STATS = 101 * MiB;
constexpr size_t WS_R1 = 112 * MiB;
constexpr size_t WS_R2 = 240 * MiB;
constexpr size_t WS_R3 = 368 * MiB;
constexpr size_t WS_END = 496 * MiB;

__device__ __forceinline__ unsigned cvt_pk_bf16(float lo, float hi) { unsigned r; asm volatile("v_cvt_pk_bf16_f32 %0, %1, %2" : "=v"(r) : "v"(lo), "v"(hi)); return r; }
__device__ __forceinline__ float bf_lo(unsigned w) { return __uint_as_float(w << 16); }
__device__ __forceinline__ float bf_hi(unsigned w) { return __uint_as_float(w & 0xffff0000u); }

__device__ __forceinline__ int lds_byte(int r, int c) { const int st = (r >> 4) * 2 + (c >> 5), rr = r & 15, cc = c & 31, ob = rr * 64 + cc * 2; return st * 1024 + (ob ^ (((ob >> 9) & 1) << 5)); }
__device__ __forceinline__ void stage_rc(int b, int& R, int& C) { const int st = b / 1024, sb = b % 1024, swz = sb ^ (((sb >> 9) & 1) << 5); R = (st >> 1) * 16 + swz / 64; C = (st & 1) * 32 + (swz % 64) / 2; }
__device__ __forceinline__ int perm32(int rho) { const int n = rho >> 4, i = rho & 15; return 8 * (i >> 2) + 4 * n + (i & 3); }

struct Unit { int pm, pn; };
struct Gemm { const bf16_t* A; const bf16_t* Bt; int lda, ldb, K; long a_pm, a_pn, b_pm, b_pn; };

struct StaticOrder {
    int nM, nN, nwg, G, c;
    __device__ void init(int nM_, int nN_, int G_, int c_) { nM = nM_; nN = nN_; nwg = nM * nN; G = G_; c = c_; }
    __device__ bool next(int i, Unit& u) const {
        const long L = (long)i * G + c; if (L >= nwg) return false;
        int wgid = (int)L; { const int q = nwg / NXCD, r = nwg % NXCD, xcd = wgid % NXCD, off = wgid / NXCD; wgid = (xcd < r ? xcd * (q + 1) : r * (q + 1) + (xcd - r) * q) + off; }
        const int nig = WGM * nN, gid = wgid / nig, fm = gid * WGM, gsz = (nM - fm) < WGM ? (nM - fm) : WGM;
        u.pm = fm + ((wgid % nig) % gsz); u.pn = (wgid % nig) / gsz; return true;
    }
};

__device__ __forceinline__ f32x2 gelu_pk(f32x2 v) {
    const f32x2 av = __builtin_elementwise_abs(v), d = av * 0.2316418882f + 1.0f;
    f32x2 t; t.x = __builtin_amdgcn_rcpf(d.x); t.y = __builtin_amdgcn_rcpf(d.y);
    f32x2 q = t * 0.5307027145f + (-0.7265760135f); q = q * t + 0.7107068705f; q = q * t + (-0.142248368f); q = q * t + 0.127414796f; q = q * t;
    const f32x2 s = (v * v) * (-0.72134752044f);
    f32x2 e; e.x = __builtin_amdgcn_exp2f(s.x); e.y = __builtin_amdgcn_exp2f(s.y);
    const f32x2 m = v * (q * e), r = v - m;
    f32x2 o; o.x = v.x < 0.f ? m.x : r.x; o.y = v.y < 0.f ? m.y : r.y; return o;
}
__device__ __forceinline__ float silu_f(float x) { return x * __builtin_amdgcn_rcpf(1.0f + __builtin_amdgcn_exp2f(x * -1.44269504089f)); }

struct EpiGeluUV {
    static constexpr bool PERM = true;
    bf16_t* U; bf16_t* V; float* stats;
    __device__ __forceinline__ void operator()(const f32x4 (&acc)[2][2][4][2], const Unit& u, int wr, int wc, int fr, int fq) const {
        const int row0 = u.pm * BM + wr * 64 + fr; const bool isV = u.pn >= 8; const int colt = (u.pn & 7) * BM;
        bf16_t* base = isV ? V : U; const int col0 = colt + wc * 32 + 8 * fq;
#pragma unroll
        for (int ai = 0; ai < 2; ++ai)
#pragma unroll
            for (int m = 0; m < 4; ++m) { const int row = row0 + ai * HALF + m * 16; bf16_t* rowp = base + (size_t)row * AW + col0; float s = 0.f, q = 0.f;
#pragma unroll
                for (int bj = 0; bj < 2; ++bj) { const f32x4 v0 = acc[ai][bj][m][0], v1 = acc[ai][bj][m][1];
                    const f32x2 a = gelu_pk((f32x2){v0[0], v0[1]}), b = gelu_pk((f32x2){v0[2], v0[3]}), c = gelu_pk((f32x2){v1[0], v1[1]}), d = gelu_pk((f32x2){v1[2], v1[3]});
                    s += (a.x + a.y) + (b.x + b.y) + (c.x + c.y) + (d.x + d.y);
                    q += (a.x * a.x + a.y * a.y) + (b.x * b.x + b.y * b.y) + (c.x * c.x + c.y * c.y) + (d.x * d.x + d.y * d.y);
                    u32x4 w; w.x = cvt_pk_bf16(a.x, a.y); w.y = cvt_pk_bf16(b.x, b.y); w.z = cvt_pk_bf16(c.x, c.y); w.w = cvt_pk_bf16(d.x, d.y);
                    *(u32x4*)(rowp + bj * HALF) = w; }
                if (isV) { s += __shfl_xor(s, 16); s += __shfl_xor(s, 32); q += __shfl_xor(q, 16); q += __shfl_xor(q, 32);
                    if (fq == 0) *(f32x2*)(stats + ((size_t)row * 32 + (u.pn - 8) * 4 + wc) * 2) = (f32x2){s, q}; } }
    }
};
struct EpiGate {
    static constexpr bool PERM = true;
    const bf16_t* U; bf16_t* O; const float* bs;
    __device__ __forceinline__ void operator()(const f32x4 (&acc)[2][2][4][2], const Unit& u, int wr, int wc, int fr, int fq) const {
        const int row0 = u.pm * BM + wr * 64 + fr; const int col0 = u.pn * BM + wc * 32 + 8 * fq;
#pragma unroll
        for (int ai = 0; ai < 2; ++ai)
#pragma unroll
            for (int m = 0; m < 4; ++m) { const int row = row0 + ai * HALF + m * 16; const float bias = bs[u.pn * 128 + wr * 64 + m * 16 + fr];
                const size_t off = (size_t)row * AW + col0;
#pragma unroll
                for (int bj = 0; bj < 2; ++bj) { const u32x4 uu = *(const u32x4*)(U + off + bj * HALF); const f32x4 v0 = acc[ai][bj][m][0] + bias, v1 = acc[ai][bj][m][1] + bias;
                    u32x4 w; w.x = cvt_pk_bf16(bf_lo(uu.x) * v0[0], bf_hi(uu.x) * v0[1]); w.y = cvt_pk_bf16(bf_lo(uu.y) * v0[2], bf_hi(uu.y) * v0[3]);
                    w.z = cvt_pk_bf16(bf_lo(uu.z) * v1[0], bf_hi(uu.z) * v1[1]); w.w = cvt_pk_bf16(bf_lo(uu.w) * v1[2], bf_hi(uu.w) * v1[3]);
                    *(u32x4*)(O + off + bj * HALF) = w; } }
    }
};
struct EpiBf16S {
    static constexpr bool PERM = true;
    bf16_t* O; int ldc; const float* scale;
    __device__ __forceinline__ void operator()(const f32x4 (&acc)[2][2][4][2], const Unit& u, int wr, int wc, int fr, int fq) const {
        const int row0 = u.pm * BM + wr * 64 + fr; const int col0 = u.pn * BM + wc * 32 + 8 * fq;
        f32x4 sv[2][2];
#pragma unroll
        for (int bj = 0; bj < 2; ++bj)
#pragma unroll
            for (int n = 0; n < 2; ++n) sv[bj][n] = scale ? *(const f32x4*)(scale + col0 + bj * HALF + 4 * n) : (f32x4){1.f, 1.f, 1.f, 1.f};
#pragma unroll
        for (int ai = 0; ai < 2; ++ai)
#pragma unroll
            for (int m = 0; m < 4; ++m) { bf16_t* rowp = O + (size_t)(row0 + ai * HALF + m * 16) * ldc + col0;
#pragma unroll
                for (int bj = 0; bj < 2; ++bj) { const f32x4 v0 = acc[ai][bj][m][0] * sv[bj][0], v1 = acc[ai][bj][m][1] * sv[bj][1];
                    u32x4 w; w.x = cvt_pk_bf16(v0[0], v0[1]); w.y = cvt_pk_bf16(v0[2], v0[3]); w.z = cvt_pk_bf16(v1[0], v1[1]); w.w = cvt_pk_bf16(v1[2], v1[3]);
                    *(u32x4*)(rowp + bj * HALF) = w; } }
    }
};
struct EpiF32 {
    static constexpr bool PERM = false;
    float* C; int ldc;
    __device__ __forceinline__ void operator()(const f32x4 (&acc)[2][2][4][2], const Unit& u, int wr, int wc, int fr, int fq) const {
        const int row0 = u.pm * BM + wr * 64 + fr, col0 = u.pn * BM + wc * 32 + 4 * fq;
#pragma unroll
        for (int ai = 0; ai < 2; ++ai)
#pragma unroll
            for (int m = 0; m < 4; ++m) { float* rowp = C + (size_t)(row0 + ai * HALF + m * 16) * ldc + col0;
#pragma unroll
                for (int bj = 0; bj < 2; ++bj)
#pragma unroll
                    for (int n = 0; n < 2; ++n) *(f32x4*)(rowp + bj * HALF + n * 16) = acc[ai][bj][m][n]; }
    }
};
struct EpiSwiGLU {
    static constexpr bool PERM = true;
    bf16_t* O;
    __device__ __forceinline__ void operator()(const f32x4 (&acc)[2][2][4][2], const Unit& u, int wr, int wc, int fr, int fq) const {
        const int row0 = u.pm * BM + wr * 64 + fr; const int col0 = u.pn * HALF + wc * 32 + 8 * fq;
#pragma unroll
        for (int ai = 0; ai < 2; ++ai)
#pragma unroll
            for (int m = 0; m < 4; ++m) { bf16_t* rowp = O + (size_t)(row0 + ai * HALF + m * 16) * DFF + col0;
                const f32x4 g0 = acc[ai][0][m][0], g1 = acc[ai][0][m][1], u0 = acc[ai][1][m][0], u1 = acc[ai][1][m][1];
                u32x4 w; w.x = cvt_pk_bf16(silu_f(g0[0]) * u0[0], silu_f(g0[1]) * u0[1]); w.y = cvt_pk_bf16(silu_f(g0[2]) * u0[2], silu_f(g0[3]) * u0[3]);
                w.z = cvt_pk_bf16(silu_f(g1[0]) * u1[0], silu_f(g1[1]) * u1[1]); w.w = cvt_pk_bf16(silu_f(g1[2]) * u1[2], silu_f(g1[3]) * u1[3]);
                *(u32x4*)rowp = w; }
    }
};

template <class Epi>
__device__ __forceinline__ void gemm_phase(LAS unsigned char* lds, const int tid, const Gemm g, const StaticOrder& S, const Epi& E) {
    const int wid = __builtin_amdgcn_readfirstlane(tid >> 6), lane = tid & 63, wr = wid >> 2, wc = wid & 3, fr = lane & 15, fq = lane >> 4;
    int K = g.K; asm volatile("" : "+s"(K)); const int nt = K / BK;
    unsigned voffA[2], voffB[2];
#pragma unroll
    for (int i = 0; i < 2; ++i) { int R, C; stage_rc(tid * 16 + i * 8192, R, C); const int Rb = Epi::PERM ? ((R & ~31) + perm32(R & 31)) : R;
        voffA[i] = (unsigned)(R * g.lda + C) * 2u; voffB[i] = (unsigned)(Rb * g.ldb + C) * 2u; }
    const size_t kstep = (size_t)(BK * 2);
    const size_t hstepA = (size_t)HALF * g.lda * 2, hstepB = (size_t)HALF * g.ldb * 2;
    const unsigned ldsw = (unsigned)wid * 1024u;
    const int aoff = lds_byte(wr * 64 + fr, fq * 8), boff = lds_byte(wc * 32 + fr, fq * 8);
#define PG8_SA(b, h) (((b) * 2 + (h)) * HTB)
#define PG8_SB(b, h) ((4 + (b) * 2 + (h)) * HTB)
#define PG8_STAGE(bufoff, gbase, voff) do { _Pragma("unroll") for (int _i = 0; _i < 2; ++_i) \
        __builtin_amdgcn_global_load_lds((const unsigned*)((const char*)(gbase) + (voff)[_i]), (LAS unsigned*)(lds + (bufoff) + ldsw + _i * 8192), 16, 0, 0); } while (0)
#define PG8_LDA(dst, b, h) do { _Pragma("unroll") for (int m = 0; m < 4; ++m) _Pragma("unroll") for (int k = 0; k < 2; ++k) dst[m][k] = *(const LAS bf16x8*)(lds + PG8_SA(b, h) + aoff + m * 2048 + k * 1024); } while (0)
#define PG8_LDB(dst, b, h) do { _Pragma("unroll") for (int n = 0; n < 2; ++n) _Pragma("unroll") for (int k = 0; k < 2; ++k) dst[n][k] = *(const LAS bf16x8*)(lds + PG8_SB(b, h) + boff + n * 2048 + k * 1024); } while (0)
#define PG8_MMA(ai, bj, At, Bt) do { __builtin_amdgcn_s_setprio(1); _Pragma("unroll") for (int m = 0; m < 4; ++m) _Pragma("unroll") for (int n = 0; n < 2; ++n) _Pragma("unroll") for (int k = 0; k < 2; ++k) \
        acc[ai][bj][m][n] = __builtin_amdgcn_mfma_f32_16x16x32_bf16(Bt[n][k], At[m][k], acc[ai][bj][m][n], 0, 0, 0); __builtin_amdgcn_s_setprio(0); } while (0)
#define PG8_WAIT_V(n) asm volatile("s_waitcnt vmcnt(" #n ")" ::: "memory")
#define PG8_WAIT_L(n) asm volatile("s_waitcnt lgkmcnt(" #n ")" ::: "memory")
#define PG8_BAR __builtin_amdgcn_s_barrier()
#define PG8_SCHED __builtin_amdgcn_sched_barrier(0)
    Unit cur, nxt; int ui = 0;
    if (!S.next(0, cur)) return;
    f32x4 acc[2][2][4][2];
#pragma unroll
    for (int a = 0; a < 2; ++a)
#pragma unroll
        for (int b = 0; b < 2; ++b)
#pragma unroll
            for (int m = 0; m < 4; ++m)
#pragma unroll
                for (int n = 0; n < 2; ++n) acc[a][b][m][n] = (f32x4){0.f, 0.f, 0.f, 0.f};
    bf16x8 At[4][2], B0[2][2], B1[2][2];
    const char* cA = (const char*)(g.A + (size_t)cur.pm * g.a_pm + (size_t)cur.pn * g.a_pn); const char* cB = (const char*)(g.Bt + (size_t)cur.pm * g.b_pm + (size_t)cur.pn * g.b_pn);
    PG8_STAGE(PG8_SB(0, 0), cB, voffB); PG8_STAGE(PG8_SB(0, 1), cB + hstepB, voffB); PG8_STAGE(PG8_SA(0, 0), cA, voffA); PG8_STAGE(PG8_SA(0, 1), cA + hstepA, voffA);
    if (wr == 1) PG8_BAR;
    PG8_WAIT_V(2); PG8_BAR;
    PG8_STAGE(PG8_SB(1, 0), cB + kstep, voffB); PG8_STAGE(PG8_SA(1, 0), cA + kstep, voffA); PG8_STAGE(PG8_SB(1, 1), cB + hstepB + kstep, voffB);
    PG8_WAIT_V(6); PG8_BAR;
    for (;;) {
        const bool has_next = S.next(ui + 1, nxt);
        const char* nA = has_next ? (const char*)(g.A + (size_t)nxt.pm * g.a_pm + (size_t)nxt.pn * g.a_pn) : cA;
        const char* nB = has_next ? (const char*)(g.Bt + (size_t)nxt.pm * g.b_pm + (size_t)nxt.pn * g.b_pn) : cB;
        for (int t = 0; t < nt; t += 2) {
            const bool last = (t == nt - 2);
            const char* a1 = cA + (size_t)(t + 1) * kstep;
            const char* a2 = last ? nA : cA + (size_t)(t + 2) * kstep; const char* b2 = last ? nB : cB + (size_t)(t + 2) * kstep;
            const char* a3 = a2 + kstep; const char* b3 = b2 + kstep;
            PG8_LDB(B0, 0, 0); PG8_LDB(B1, 0, 1); PG8_SCHED; PG8_LDA(At, 0, 0); PG8_STAGE(PG8_SA(1, 1), a1 + hstepA, voffA);
            PG8_WAIT_V(8); PG8_WAIT_L(0); PG8_BAR; PG8_MMA(0, 0, At, B0); PG8_MMA(0, 1, At, B1); PG8_BAR; PG8_SCHED;
            PG8_LDA(At, 0, 1); PG8_STAGE(PG8_SB(0, 0), b2, voffB); PG8_STAGE(PG8_SB(0, 1), b2 + hstepB, voffB); PG8_STAGE(PG8_SA(0, 0), a2, voffA);
            PG8_WAIT_V(8); PG8_WAIT_L(0); PG8_BAR; PG8_MMA(1, 0, At, B0); PG8_MMA(1, 1, At, B1); PG8_BAR; PG8_SCHED;
            PG8_LDB(B0, 1, 0); PG8_LDB(B1, 1, 1); PG8_SCHED; PG8_LDA(At, 1, 0); PG8_STAGE(PG8_SA(0, 1), a2 + hstepA, voffA);
            PG8_WAIT_V(8); PG8_WAIT_L(0); PG8_BAR; PG8_MMA(0, 0, At, B0); PG8_MMA(0, 1, At, B1); PG8_BAR; PG8_SCHED;
            PG8_LDA(At, 1, 1); PG8_STAGE(PG8_SB(1, 0), b3, voffB); PG8_STAGE(PG8_SB(1, 1), b3 + hstepB, voffB); PG8_STAGE(PG8_SA(1, 0), a3, voffA);
            PG8_WAIT_V(8); PG8_WAIT_L(0); PG8_BAR; PG8_MMA(1, 0, At, B0); PG8_MMA(1, 1, At, B1); PG8_BAR; PG8_SCHED;
        }
        if (wr == 0) PG8_BAR;
        E(acc, cur, wr, wc, fr, fq);
        if (!has_next) break;
#pragma unroll
        for (int a = 0; a < 2; ++a)
#pragma unroll
            for (int b = 0; b < 2; ++b)
#pragma unroll
                for (int m = 0; m < 4; ++m)
#pragma unroll
                    for (int n = 0; n < 2; ++n) acc[a][b][m][n] = (f32x4){0.f, 0.f, 0.f, 0.f};
        cur = nxt; cA = nA; cB = nB; ++ui;
        if (wr == 1) PG8_BAR;
    }
    PG8_WAIT_V(0);
    PG8_BAR;
#undef PG8_SA
#undef PG8_SB
#undef PG8_STAGE
#undef PG8_LDA
#undef PG8_LDB
#undef PG8_MMA
#undef PG8_WAIT_V
#undef PG8_WAIT_L
#undef PG8_BAR
#undef PG8_SCHED
}

__device__ __forceinline__ void tr_cvt(LAS unsigned char* lds, const int tid, const float* src, int K, int N, int ld_src, bf16_t* dst, int ldd, int rm, int& base) {
    LAS float* T = (LAS float*)lds;
    const int G = gridDim.x;
    const int tk = K / 64, tn = N / 64, ntiles = tk * tn;
    const int t0 = (int)((blockIdx.x + G - (base % G)) % G);
    for (int t = t0; t < ntiles; t += G) {
        const int kt = t / tn, ntile = t % tn; const int k0 = kt * 64, n0 = ntile * 64;
        __syncthreads();
#pragma unroll
        for (int i = 0; i < 2; ++i) { const int kk = (tid >> 4) + i * 32, n4 = (tid & 15) * 4;
            const f32x4 v = *(const f32x4*)(src + (size_t)(k0 + kk) * ld_src + n0 + n4);
            T[kk * 65 + n4 + 0] = v[0]; T[kk * 65 + n4 + 1] = v[1]; T[kk * 65 + n4 + 2] = v[2]; T[kk * 65 + n4 + 3] = v[3]; }
        __syncthreads();
        { const int n = tid >> 3, k8 = (tid & 7) * 8; float f[8];
#pragma unroll
          for (int j = 0; j < 8; ++j) f[j] = T[(k8 + j) * 65 + n];
          u32x4 w; w.x = cvt_pk_bf16(f[0], f[1]); w.y = cvt_pk_bf16(f[2], f[3]); w.z = cvt_pk_bf16(f[4], f[5]); w.w = cvt_pk_bf16(f[6], f[7]);
          const int nn = n0 + n; const int drow = rm == 0 ? nn : ((nn >> 7) * 256 + (nn & 127) + (rm == 2 ? 128 : 0));
          *(u32x4*)(dst + (size_t)drow * ldd + k0 + k8) = w; }
    }
    base += ntiles;
}
__device__ __forceinline__ void build_ws(const int tid, const float* ws_in, bf16_t* dst) {
    const int total = 16 * 256 * 32;
    for (int p = blockIdx.x * NTHREADS + tid; p < total; p += gridDim.x * NTHREADS) {
        const int lg = p / (256 * 32), t = (p / 32) % 256, s8 = (p % 32) * 8; float f[8];
#pragma unroll
        for (int j = 0; j < 8; ++j) { const int s = s8 + j; const bool keep = ((t >> 7) == (s >> 7)) && ((s & 127) <= (t & 127));
            f[j] = keep ? ws_in[(size_t)lg * 16384 + (t & 127) * 128 + (s & 127)] : 0.f; }
        u32x4 w; w.x = cvt_pk_bf16(f[0], f[1]); w.y = cvt_pk_bf16(f[2], f[3]); w.z = cvt_pk_bf16(f[4], f[5]); w.w = cvt_pk_bf16(f[6], f[7]);
        *(u32x4*)(dst + (size_t)lg * 65536 + t * 256 + s8) = w;
    }
}
__device__ __forceinline__ void norm_pass(const int tid, const float* xin, const bf16_t* mo, const float* gpost, const float* gpre, float* xout, bf16_t* hout) {
    const int lane = tid & 63, wid = tid >> 6;
    f32x4 gp[4], gq[4];
#pragma unroll
    for (int i = 0; i < 4; ++i) { gp[i] = mo ? *(const f32x4*)(gpost + i * 256 + lane * 4) : (f32x4){0.f, 0.f, 0.f, 0.f}; gq[i] = hout ? *(const f32x4*)(gpre + i * 256 + lane * 4) : (f32x4){0.f, 0.f, 0.f, 0.f}; }
    for (int row = blockIdx.x * 8 + wid; row < MTOK; row += gridDim.x * 8) {
        f32x4 x[4];
#pragma unroll
        for (int i = 0; i < 4; ++i) x[i] = *(const f32x4*)(xin + (size_t)row * DM + i * 256 + lane * 4);
        if (mo) {
            f32x4 mv[4]; float q = 0.f;
#pragma unroll
            for (int i = 0; i < 4; ++i) { const u32x2 w = *(const u32x2*)(mo + (size_t)row * DM + i * 256 + lane * 4); mv[i] = (f32x4){bf_lo(w.x), bf_hi(w.x), bf_lo(w.y), bf_hi(w.y)};
                q += (mv[i][0] * mv[i][0] + mv[i][1] * mv[i][1]) + (mv[i][2] * mv[i][2] + mv[i][3] * mv[i][3]); }
#pragma unroll
            for (int o = 32; o >= 1; o >>= 1) q += __shfl_xor(q, o);
            const float rs = 1.0f / sqrtf(q * (1.0f / DM) + EPS);
#pragma unroll
            for (int i = 0; i < 4; ++i) x[i] += mv[i] * rs * gp[i];
        }
        if (xout) {
#pragma unroll
            for (int i = 0; i < 4; ++i) *(f32x4*)(xout + (size_t)row * DM + i * 256 + lane * 4) = x[i];
        }
        if (hout) {
            float q = 0.f;
#pragma unroll
            for (int i = 0; i < 4; ++i) q += (x[i][0] * x[i][0] + x[i][1] * x[i][1]) + (x[i][2] * x[i][2] + x[i][3] * x[i][3]);
#pragma unroll
            for (int o = 32; o >= 1; o >>= 1) q += __shfl_xor(q, o);
            const float rs = 1.0f / sqrtf(q * (1.0f / DM) + EPS);
#pragma unroll
            for (int i = 0; i < 4; ++i) { const f32x4 h = x[i] * rs * gq[i]; u32x2 w; w.x = cvt_pk_bf16(h[0], h[1]); w.y = cvt_pk_bf16(h[2], h[3]);
                *(u32x2*)(hout + (size_t)row * DM + i * 256 + lane * 4) = w; }
        }
    }
}
__device__ __forceinline__ void lnt_pass(LAS unsigned char* lds, const int tid, const bf16_t* V, const float* stats, const float* lg, const float* lb, bf16_t* VnT) {
    LAS unsigned* T = (LAS unsigned*)lds;
    LAS f32x2* MR = (LAS f32x2*)(lds + 32768);
    for (int strip = blockIdx.x; strip < MTOK / 128; strip += gridDim.x) {
        const int t0 = strip * 128;
        __syncthreads();
        if (tid < 128) { const f32x4* sp = (const f32x4*)(stats + (size_t)(t0 + tid) * 64); float s = 0.f, q = 0.f;
#pragma unroll
            for (int i = 0; i < 16; ++i) { const f32x4 v = sp[i]; s += v[0] + v[2]; q += v[1] + v[3]; }
            const float mean = s * (1.0f / AW); const float var = fmaxf(q * (1.0f / AW) - mean * mean, 0.f);
            MR[tid] = (f32x2){mean, 1.0f / sqrtf(var + EPS)}; }
        __syncthreads();
        for (int ct = 0; ct < AW / 128; ++ct) {
            const int c0 = ct * 128;
#pragma unroll
            for (int i = 0; i < 2; ++i) { const int o = tid + i * 512, c8i = o & 15, rp = o >> 4; const int c = c0 + c8i * 8;
                const u32x4 r0 = *(const u32x4*)(V + (size_t)(t0 + 2 * rp) * AW + c), r1 = *(const u32x4*)(V + (size_t)(t0 + 2 * rp + 1) * AW + c);
                const f32x4 g0 = *(const f32x4*)(lg + c), g1 = *(const f32x4*)(lg + c + 4), b0 = *(const f32x4*)(lb + c), b1 = *(const f32x4*)(lb + c + 4);
                const f32x2 m0 = MR[2 * rp], m1 = MR[2 * rp + 1];
                const unsigned ra[4] = {r0.x, r0.y, r0.z, r0.w}, rb[4] = {r1.x, r1.y, r1.z, r1.w};
                const float gg[8] = {g0[0], g0[1], g0[2], g0[3], g1[0], g1[1], g1[2], g1[3]}, bb[8] = {b0[0], b0[1], b0[2], b0[3], b1[0], b1[1], b1[2], b1[3]};
                const int pcol = (rp + 4 * c8i) & 63;
#pragma unroll
                for (int j = 0; j < 4; ++j) {
                    const float a_lo = (bf_lo(ra[j]) - m0.x) * m0.y * gg[2 * j] + bb[2 * j], a_hi = (bf_hi(ra[j]) - m0.x) * m0.y * gg[2 * j + 1] + bb[2 * j + 1];
                    const float b_lo = (bf_lo(rb[j]) - m1.x) * m1.y * gg[2 * j] + bb[2 * j], b_hi = (bf_hi(rb[j]) - m1.x) * m1.y * gg[2 * j + 1] + bb[2 * j + 1];
                    T[(c8i * 8 + 2 * j) * 64 + pcol] = cvt_pk_bf16(a_lo, b_lo);
                    T[(c8i * 8 + 2 * j + 1) * 64 + pcol] = cvt_pk_bf16(a_hi, b_hi);
                } }
            __syncthreads();
#pragma unroll
            for (int i = 0; i < 4; ++i) { const int o = tid + i * 512, cl = o >> 4, q = o & 15; const int ph = (4 * q + 4 * (cl >> 3)) & 63;
                const u32x4 w = *(const LAS u32x4*)(T + cl * 64 + ph);
                *(u32x4*)(VnT + (size_t)(c0 + cl) * MTOK + t0 + 8 * q) = w; }
            __syncthreads();
        }
    }
}
__device__ __forceinline__ void pool_pass(const int tid, const float* P, bf16_t* O) {
    const size_t total = (size_t)MTOK * 256;
    for (size_t idx = (size_t)blockIdx.x * NTHREADS + tid; idx < total; idx += (size_t)gridDim.x * NTHREADS) {
        const int t = (int)(idx >> 8), c4 = (int)(idx & 255) * 4; const int win = 2 << (c4 >> 8); const int tin = t & (SEQ - 1); const int cnt = (tin + 1) < win ? (tin + 1) : win;
        const float* p = P + (size_t)t * DM + c4; const f32x4 self = *(const f32x4*)p; f32x4 s = self;
        for (int j = 1; j < cnt; ++j) s += *(const f32x4*)(p - (size_t)j * DM);
        const float inv = 1.0f / (float)cnt; const f32x4 r = s * inv - self;
        u32x2 w; w.x = cvt_pk_bf16(r[0], r[1]); w.y = cvt_pk_bf16(r[2], r[3]); *(u32x2*)(O + (size_t)t * DM + c4) = w;
    }
}

struct Args { const float* in[18]; float* out; unsigned char* ws; int ph_lo, ph_hi; };
constexpr int N_PHASES = 1 + DEPTH * 8;

__global__ void __launch_bounds__(NTHREADS, 2) fwd_mega(Args a) {
    extern __shared__ __attribute__((aligned(16))) unsigned char lds_raw[];
    LAS unsigned char* lds = (LAS unsigned char*)lds_raw;
    cg::grid_group grid = cg::this_grid();
    unsigned char* ws = a.ws;
    const float* x_in = a.in[0];
    bf16_t* U = (bf16_t*)(ws + WS_R1); float* P = (float*)(ws + WS_R1); bf16_t* ACT = (bf16_t*)(ws + WS_R1);
    bf16_t* V = (bf16_t*)(ws + WS_R2); bf16_t* GT = (bf16_t*)(ws + WS_R2); bf16_t* POOL = (bf16_t*)(ws + WS_R2); bf16_t* MIX = (bf16_t*)(ws + WS_R2 + 64 * MiB);
    bf16_t* H = (bf16_t*)(ws + WS_R3); bf16_t* MO = (bf16_t*)(ws + WS_R3 + 64 * MiB); bf16_t* VNT = (bf16_t*)(ws + WS_R3);
    float* STATS = (float*)(ws + WS_STATS);
    const int G = gridDim.x, bid = blockIdx.x;

    for (int ph = a.ph_lo; ph < a.ph_hi; ++ph) {
        int tid = threadIdx.x; asm volatile("" : "+v"(tid));
        if (ph == 0 && (PHMASK & 1)) {
            int base = 0;
            for (int j = 0; j < 2; ++j) {
                tr_cvt(lds, tid, a.in[1] + (size_t)j * DM * 4096, DM, 4096, 4096, (bf16_t*)(ws + WS_AWIN) + (size_t)j * 4096 * DM, DM, 0, base);
                tr_cvt(lds, tid, a.in[6] + (size_t)j * AW * DM, AW, DM, DM, (bf16_t*)(ws + WS_AWOUT) + (size_t)j * DM * AW, AW, 0, base);
                tr_cvt(lds, tid, a.in[7] + (size_t)j * DM * DM, DM, DM, DM, (bf16_t*)(ws + WS_BWIN) + (size_t)j * DM * DM, DM, 0, base);
                for (int g = 0; g < 4; ++g) tr_cvt(lds, tid, a.in[8] + (size_t)(j * 4 + g) * 65536, 256, 256, 256, (bf16_t*)(ws + WS_BWGRP) + (size_t)(j * 4 + g) * 65536, 256, 0, base);
                tr_cvt(lds, tid, a.in[10] + (size_t)j * DM * DM, DM, DM, DM, (bf16_t*)(ws + WS_BWOUT) + (size_t)j * DM * DM, DM, 0, base);
            }
            for (int i = 0; i < DEPTH; ++i) {
                tr_cvt(lds, tid, a.in[15] + (size_t)i * DM * DFF, DM, DFF, DFF, (bf16_t*)(ws + WS_FGU) + (size_t)i * 2 * DFF * DM, DM, 1, base);
                tr_cvt(lds, tid, a.in[16] + (size_t)i * DM * DFF, DM, DFF, DFF, (bf16_t*)(ws + WS_FGU) + (size_t)i * 2 * DFF * DM, DM, 2, base);
                tr_cvt(lds, tid, a.in[17] + (size_t)i * DFF * DM, DFF, DM, DM, (bf16_t*)(ws + WS_FDN) + (size_t)i * DM * DFF, DFF, 0, base);
            }
            build_ws(tid, a.in[4], (bf16_t*)(ws + WS_AWS));
            norm_pass(tid, x_in, nullptr, nullptr, a.in[11], nullptr, H);
        } else {
            const int li = (ph - 1) >> 3, st = (ph - 1) & 7, j = li >> 1; const bool isB = li & 1;
            if (st == 0) {
                if (!isB && (PHMASK & 2)) {
                    Gemm g{H, (const bf16_t*)(ws + WS_AWIN) + (size_t)j * 4096 * DM, DM, DM, DM, (long)BM * DM, 0, 0, (long)BM * DM};
                    StaticOrder S; S.init(MTOK / BM, 4096 / BM, G, bid); EpiGeluUV E{U, V, STATS};
                    gemm_phase(lds, tid, g, S, E);
                } else if (isB && (PHMASK & 4)) {
                    Gemm g{H, (const bf16_t*)(ws + WS_BWIN) + (size_t)j * DM * DM, DM, DM, DM, (long)BM * DM, 0, 0, (long)BM * DM};
                    StaticOrder S; S.init(MTOK / BM, DM / BM, G, bid); EpiF32 E{P, DM};
                    gemm_phase(lds, tid, g, S, E);
                }
            } else if (st == 1) {
                if (!isB && (PHMASK & 8)) lnt_pass(lds, tid, V, STATS, a.in[2] + j * AW, a.in[3] + j * AW, VNT);
                else if (isB && (PHMASK & 16)) pool_pass(tid, P, POOL);
            } else if (st == 2) {
                if (!isB && (PHMASK & 32)) {
                    Gemm g{(const bf16_t*)(ws + WS_AWS) + (size_t)j * 8 * 65536, VNT, 256, MTOK, 256, 0, 65536, 256, (long)256 * MTOK};
                    StaticOrder S; S.init(MTOK / BM, 8, G, bid); EpiGate E{U, GT, a.in[5] + j * 8 * 128};
                    gemm_phase(lds, tid, g, S, E);
                } else if (isB && (PHMASK & 64)) {
                    Gemm g{POOL, (const bf16_t*)(ws + WS_BWGRP) + (size_t)j * 4 * 65536, DM, 256, 256, (long)BM * DM, 256, 0, 65536};
                    StaticOrder S; S.init(MTOK / BM, 4, G, bid); EpiBf16S E{MIX, DM, a.in[9] + j * DM};
                    gemm_phase(lds, tid, g, S, E);
                }
            } else if ((st == 3 || st == 6) && (PHMASK & 128)) {
                Gemm g;
                if (st == 6) g = Gemm{ACT, (const bf16_t*)(ws + WS_FDN) + (size_t)li * DM * DFF, DFF, DFF, DFF, (long)BM * DFF, 0, 0, (long)BM * DFF};
                else if (!isB) g = Gemm{GT, (const bf16_t*)(ws + WS_AWOUT) + (size_t)j * DM * AW, AW, AW, AW, (long)BM * AW, 0, 0, (long)BM * AW};
                else g = Gemm{MIX, (const bf16_t*)(ws + WS_BWOUT) + (size_t)j * DM * DM, DM, DM, DM, (long)BM * DM, 0, 0, (long)BM * DM};
                StaticOrder S; S.init(MTOK / BM, DM / BM, G, bid); EpiBf16S E{MO, DM, nullptr};
                gemm_phase(lds, tid, g, S, E);
            } else if (st == 4 && (PHMASK & 256)) {
                norm_pass(tid, li == 0 ? x_in : a.out, MO, a.in[12] + li * DM, a.in[13] + li * DM, a.out, H);
            } else if (st == 5 && (PHMASK & 512)) {
                Gemm g{H, (const bf16_t*)(ws + WS_FGU) + (size_t)li * 2 * DFF * DM, DM, DM, DM, (long)BM * DM, 0, 0, (long)BM * DM};
                StaticOrder S; S.init(MTOK / BM, 2 * DFF / BM, G, bid); EpiSwiGLU E{ACT};
                gemm_phase(lds, tid, g, S, E);
            } else if (st == 7 && (PHMASK & 1024)) {
                const bool lastl = (li == DEPTH - 1);
                norm_pass(tid, a.out, MO, a.in[14] + li * DM, lastl ? a.in[11] : a.in[11] + (li + 1) * DM, a.out, lastl ? nullptr : H);
            }
        }
        if (ph + 1 < a.ph_hi) grid.sync();
    }
}

extern "C" void kernel_launch(void* const* d_in, const int* in_sizes, int n_in, void* d_out, int out_size, void* d_ws, size_t ws_size, hipStream_t stream) {
    static int grid = 0;
    if (grid == 0) {
        if (n_in != 18 || ws_size < WS_END) { fprintf(stderr, "kernel_launch: unexpected n_in %d / ws %zu\n", n_in, ws_size); grid = -1; return; }
        int dev = 0, cus = 0, per_cu = 0;
        hipGetDevice(&dev); hipDeviceGetAttribute(&cus, hipDeviceAttributeMultiprocessorCount, dev);
        if (hipFuncSetAttribute((const void*)fwd_mega, hipFuncAttributeMaxDynamicSharedMemorySize, LDS_BYTES) != hipSuccess) { fprintf(stderr, "kernel_launch: hipFuncSetAttribute failed\n"); grid = -1; return; }
        if (hipOccupancyMaxActiveBlocksPerMultiprocessor(&per_cu, (const void*)fwd_mega, NTHREADS, LDS_BYTES) != hipSuccess || per_cu < 1) { fprintf(stderr, "kernel_launch: occupancy query says %d\n", per_cu); per_cu = 1; }
        (void)hipGetLastError();
        grid = cus;
    }
    if (grid < 0) return;
    Args a{};
    for (int i = 0; i < 18; ++i) a.in[i] = (const float*)d_in[i];
    a.out = (float*)d_out; a.ws = (unsigned char*)d_ws;
#if N_LAUNCH_MODE == 1
    for (int ph = 0; ph < N_PHASES; ++ph) { a.ph_lo = ph; a.ph_hi = ph + 1; hipLaunchKernelGGL(fwd_mega, dim3(grid), dim3(NTHREADS), LDS_BYTES, stream, a); }
#else
    a.ph_lo = 0; a.ph_hi = N_PHASES;
    void* args[] = {&a};
    hipError_t e = hipLaunchCooperativeKernel((const void*)fwd_mega, dim3(grid), dim3(NTHREADS), args, LDS_BYTES, stream);
    if (e != hipSuccess) fprintf(stderr, "cooperative launch failed: %s (grid %d)\n", hipGetErrorString(e), grid);
#endif
}
```

```cpp
#include <hip/hip_runtime.h>
#include <hip/hip_cooperative_groups.h>
#include <cstdio>
namespace cg = cooperative_groups;

#ifndef N_LAUNCH_MODE
#define N_LAUNCH_MODE 0
#endif

#ifndef PHMASK
#define PHMASK 0xFFFF
#endif
#define LAS __attribute__((address_space(3)))
typedef unsigned short bf16_t;
typedef short bf16x8 __attribute__((ext_vector_type(8)));
typedef float f32x4 __attribute__((ext_vector_type(4)));
typedef float f32x2 __attribute__((ext_vector_type(2)));
typedef unsigned u32x4 __attribute__((ext_vector_type(4)));
typedef unsigned u32x2 __attribute__((ext_vector_type(2)));

constexpr int MTOK = 32768, DM = 1024, SEQ = 8192, AW = 2048, DFF = 2816, DEPTH = 4;
constexpr float EPS = 1e-6f;
constexpr int BM = 256, BK = 64, HALF = 128, HTB = HALF * BK * 2, STAGE_BYTES = 8 * HTB, NXCD = 8, WGM = 8;
constexpr int LDS_BYTES = STAGE_BYTES + 64;
constexpr int NTHREADS = 512;

constexpr size_t MiB = 1024 * 1024;
constexpr size_t WS_AWIN = 0;
constexpr size_t WS_AWOUT = 16 * MiB;
constexpr size_t WS_AWS = 24 * MiB;
constexpr size_t WS_BWIN = 26 * MiB;
constexpr size_t WS_BWGRP = 30 * MiB;
constexpr size_t WS_BWOUT = 31 * MiB;
constexpr size_t WS_FGU = 35 * MiB;
constexpr size_t WS_FDN = 79 * MiB;
constexpr size_t WS_STATS = 101 * MiB;
constexpr size_t WS_BAR = 110 * MiB;
constexpr size_t WS_R1 = 112 * MiB;
constexpr size_t WS_R2 = 240 * MiB;
constexpr size_t WS_R3 = 368 * MiB;
constexpr size_t WS_END = 496 * MiB;

__device__ __forceinline__ unsigned cvt_pk_bf16(float lo, float hi) { unsigned r; asm volatile("v_cvt_pk_bf16_f32 %0, %1, %2" : "=v"(r) : "v"(lo), "v"(hi)); return r; }
__device__ __forceinline__ float bf_lo(unsigned w) { return __uint_as_float(w << 16); }
__device__ __forceinline__ float bf_hi(unsigned w) { return __uint_as_float(w & 0xffff0000u); }

__device__ __forceinline__ int lds_byte(int r, int c) { const int st = (r >> 4) * 2 + (c >> 5), rr = r & 15, cc = c & 31, ob = rr * 64 + cc * 2; return st * 1024 + (ob ^ (((ob >> 9) & 1) << 5)); }
__device__ __forceinline__ void stage_rc(int b, int& R, int& C) { const int st = b / 1024, sb = b % 1024, swz = sb ^ (((sb >> 9) & 1) << 5); R = (st >> 1) * 16 + swz / 64; C = (st & 1) * 32 + (swz % 64) / 2; }
__device__ __forceinline__ int perm32(int rho) { const int n = rho >> 4, i = rho & 15; return 8 * (i >> 2) + 4 * n + (i & 3); }

struct Unit { int pm, pn; };
struct Gemm { const bf16_t* A; const bf16_t* Bt; int lda, ldb, K; long a_pm, a_pn, b_pm, b_pn; };

struct StaticOrder {
    int nM, nN, nwg, G, c;
    __device__ void init(int nM_, int nN_, int G_, int c_) { nM = nM_; nN = nN_; nwg = nM * nN; G = G_; c = c_; }
    __device__ bool next(int i, Unit& u) const {
        const long L = (long)i * G + c; if (L >= nwg) return false;
        int wgid = (int)L; { const int q = nwg / NXCD, r = nwg % NXCD, xcd = wgid % NXCD, off = wgid / NXCD; wgid = (xcd < r ? xcd * (q + 1) : r * (q + 1) + (xcd - r) * q) + off; }
        const int nig = WGM * nN, gid = wgid / nig, fm = gid * WGM, gsz = (nM - fm) < WGM ? (nM - fm) : WGM;
        u.pm = fm + ((wgid % nig) % gsz); u.pn = (wgid % nig) / gsz; return true;
    }
};

__device__ __forceinline__ f32x2 gelu_pk(f32x2 v) {
    const f32x2 av = __builtin_elementwise_abs(v), d = av * 0.2316418882f + 1.0f;
    f32x2 t; t.x = __builtin_amdgcn_rcpf(d.x); t.y = __builtin_amdgcn_rcpf(d.y);
    f32x2 q = t * 0.5307027145f + (-0.7265760135f); q = q * t + 0.7107068705f; q = q * t + (-0.142248368f); q = q * t + 0.127414796f; q = q * t;
    const f32x2 s = (v * v) * (-0.72134752044f);
    f32x2 e; e.x = __builtin_amdgcn_exp2f(s.x); e.y = __builtin_amdgcn_exp2f(s.y);
    const f32x2 m = v * (q * e), r = v - m;
    f32x2 o; o.x = v.x < 0.f ? m.x : r.x; o.y = v.y < 0.f ? m.y : r.y; return o;
}
__device__ __forceinline__ float silu_f(float x) { return x * __builtin_amdgcn_rcpf(1.0f + __builtin_amdgcn_exp2f(x * -1.44269504089f)); }

struct EpiGeluUV {
    static constexpr bool PERM = true;
    bf16_t* U; bf16_t* V; float* stats;
    __device__ __forceinline__ void operator()(const f32x4 (&acc)[2][2][4][2], const Unit& u, int wr, int wc, int fr, int fq) const {
        const int row0 = u.pm * BM + wr * 64 + fr; const bool isV = u.pn >= 8; const int colt = (u.pn & 7) * BM;
        bf16_t* base = isV ? V : U; const int col0 = colt + wc * 32 + 8 * fq;
#pragma unroll
        for (int ai = 0; ai < 2; ++ai)
#pragma unroll
            for (int m = 0; m < 4; ++m) { const int row = row0 + ai * HALF + m * 16; bf16_t* rowp = base + (size_t)row * AW + col0; float s = 0.f, q = 0.f;
#pragma unroll
                for (int bj = 0; bj < 2; ++bj) { const f32x4 v0 = acc[ai][bj][m][0], v1 = acc[ai][bj][m][1];
                    const f32x2 a = gelu_pk((f32x2){v0[0], v0[1]}), b = gelu_pk((f32x2){v0[2], v0[3]}), c = gelu_pk((f32x2){v1[0], v1[1]}), d = gelu_pk((f32x2){v1[2], v1[3]});
                    s += (a.x + a.y) + (b.x + b.y) + (c.x + c.y) + (d.x + d.y);
                    q += (a.x * a.x + a.y * a.y) + (b.x * b.x + b.y * b.y) + (c.x * c.x + c.y * c.y) + (d.x * d.x + d.y * d.y);
                    u32x4 w; w.x = cvt_pk_bf16(a.x, a.y); w.y = cvt_pk_bf16(b.x, b.y); w.z = cvt_pk_bf16(c.x, c.y); w.w = cvt_pk_bf16(d.x, d.y);
                    *(u32x4*)(rowp + bj * HALF) = w; }
                if (isV) { s += __shfl_xor(s, 16); s += __shfl_xor(s, 32); q += __shfl_xor(q, 16); q += __shfl_xor(q, 32);
                    if (fq == 0) *(f32x2*)(stats + ((size_t)row * 32 + (u.pn - 8) * 4 + wc) * 2) = (f32x2){s, q}; } }
    }
};
struct EpiGate {
    static constexpr bool PERM = true;
    const bf16_t* U; bf16_t* O; const float* bs;
    __device__ __forceinline__ void operator()(const f32x4 (&acc)[2][2][4][2], const Unit& u, int wr, int wc, int fr, int fq) const {
        const int row0 = u.pm * BM + wr * 64 + fr; const int col0 = u.pn * BM + wc * 32 + 8 * fq;
#pragma unroll
        for (int ai = 0; ai < 2; ++ai)
#pragma unroll
            for (int m = 0; m < 4; ++m) { const int row = row0 + ai * HALF + m * 16; const float bias = bs[u.pn * 128 + wr * 64 + m * 16 + fr];
                const size_t off = (size_t)row * AW + col0;
#pragma unroll
                for (int bj = 0; bj < 2; ++bj) { const u32x4 uu = *(const u32x4*)(U + off + bj * HALF); const f32x4 v0 = acc[ai][bj][m][0] + bias, v1 = acc[ai][bj][m][1] + bias;
                    u32x4 w; w.x = cvt_pk_bf16(bf_lo(uu.x) * v0[0], bf_hi(uu.x) * v0[1]); w.y = cvt_pk_bf16(bf_lo(uu.y) * v0[2], bf_hi(uu.y) * v0[3]);
                    w.z = cvt_pk_bf16(bf_lo(uu.z) * v1[0], bf_hi(uu.z) * v1[1]); w.w = cvt_pk_bf16(bf_lo(uu.w) * v1[2], bf_hi(uu.w) * v1[3]);
                    *(u32x4*)(O + off + bj * HALF) = w; } }
    }
};
struct EpiBf16S {
    static constexpr bool PERM = true;
    bf16_t* O; int ldc; const float* scale;
    __device__ __forceinline__ void operator()(const f32x4 (&acc)[2][2][4][2], const Unit& u, int wr, int wc, int fr, int fq) const {
        const int row0 = u.pm * BM + wr * 64 + fr; const int col0 = u.pn * BM + wc * 32 + 8 * fq;
        f32x4 sv[2][2];
#pragma unroll
        for (int bj = 0; bj < 2; ++bj)
#pragma unroll
            for (int n = 0; n < 2; ++n) sv[bj][n] = scale ? *(const f32x4*)(scale + col0 + bj * HALF + 4 * n) : (f32x4){1.f, 1.f, 1.f, 1.f};
#pragma unroll
        for (int ai = 0; ai < 2; ++ai)
#pragma unroll
            for (int m = 0; m < 4; ++m) { bf16_t* rowp = O + (size_t)(row0 + ai * HALF + m * 16) * ldc + col0;
#pragma unroll
                for (int bj = 0; bj < 2; ++bj) { const f32x4 v0 = acc[ai][bj][m][0] * sv[bj][0], v1 = acc[ai][bj][m][1] * sv[bj][1];
                    u32x4 w; w.x = cvt_pk_bf16(v0[0], v0[1]); w.y = cvt_pk_bf16(v0[2], v0[3]); w.z = cvt_pk_bf16(v1[0], v1[1]); w.w = cvt_pk_bf16(v1[2], v1[3]);
                    *(u32x4*)(rowp + bj * HALF) = w; } }
    }
};
struct EpiF32 {
    static constexpr bool PERM = false;
    float* C; int ldc;
    __device__ __forceinline__ void operator()(const f32x4 (&acc)[2][2][4][2], const Unit& u, int wr, int wc, int fr, int fq) const {
        const int row0 = u.pm * BM + wr * 64 + fr, col0 = u.pn * BM + wc * 32 + 4 * fq;
#pragma unroll
        for (int ai = 0; ai < 2; ++ai)
#pragma unroll
            for (int m = 0; m < 4; ++m) { float* rowp = C + (size_t)(row0 + ai * HALF + m * 16) * ldc + col0;
#pragma unroll
                for (int bj = 0; bj < 2; ++bj)
#pragma unroll
                    for (int n = 0; n < 2; ++n) *(f32x4*)(rowp + bj * HALF + n * 16) = acc[ai][bj][m][n]; }
    }
};
struct EpiSwiGLU {
    static constexpr bool PERM = true;
    bf16_t* O;
    __device__ __forceinline__ void operator()(const f32x4 (&acc)[2][2][4][2], const Unit& u, int wr, int wc, int fr, int fq) const {
        const int row0 = u.pm * BM + wr * 64 + fr; const int col0 = u.pn * HALF + wc * 32 + 8 * fq;
#pragma unroll
        for (int ai = 0; ai < 2; ++ai)
#pragma unroll
            for (int m = 0; m < 4; ++m) { bf16_t* rowp = O + (size_t)(row0 + ai * HALF + m * 16) * DFF + col0;
                const f32x4 g0 = acc[ai][0][m][0], g1 = acc[ai][0][m][1], u0 = acc[ai][1][m][0], u1 = acc[ai][1][m][1];
                u32x4 w; w.x = cvt_pk_bf16(silu_f(g0[0]) * u0[0], silu_f(g0[1]) * u0[1]); w.y = cvt_pk_bf16(silu_f(g0[2]) * u0[2], silu_f(g0[3]) * u0[3]);
                w.z = cvt_pk_bf16(silu_f(g1[0]) * u1[0], silu_f(g1[1]) * u1[1]); w.w = cvt_pk_bf16(silu_f(g1[2]) * u1[2], silu_f(g1[3]) * u1[3]);
                *(u32x4*)rowp = w; }
    }
};

template <class Epi>
__device__ __forceinline__ void gemm_phase(LAS unsigned char* lds, const int tid, const Gemm g, const StaticOrder& S, const Epi& E) {
    const int wid = __builtin_amdgcn_readfirstlane(tid >> 6), lane = tid & 63, wr = wid >> 2, wc = wid & 3, fr = lane & 15, fq = lane >> 4;
    int K = g.K; asm volatile("" : "+s"(K)); const int nt = K / BK;
    unsigned voffA[2], voffB[2];
#pragma unroll
    for (int i = 0; i < 2; ++i) { int R, C; stage_rc(tid * 16 + i * 8192, R, C); const int Rb = Epi::PERM ? ((R & ~31) + perm32(R & 31)) : R;
        voffA[i] = (unsigned)(R * g.lda + C) * 2u; voffB[i] = (unsigned)(Rb * g.ldb + C) * 2u; }
    const size_t kstep = (size_t)(BK * 2);
    const size_t hstepA = (size_t)HALF * g.lda * 2, hstepB = (size_t)HALF * g.ldb * 2;
    const unsigned ldsw = (unsigned)wid * 1024u;
    const int aoff = lds_byte(wr * 64 + fr, fq * 8), boff = lds_byte(wc * 32 + fr, fq * 8);
#define PG8_SA(b, h) (((b) * 2 + (h)) * HTB)
#define PG8_SB(b, h) ((4 + (b) * 2 + (h)) * HTB)
#define PG8_STAGE(bufoff, gbase, voff) do { _Pragma("unroll") for (int _i = 0; _i < 2; ++_i) \
        __builtin_amdgcn_global_load_lds((const unsigned*)((const char*)(gbase) + (voff)[_i]), (LAS unsigned*)(lds + (bufoff) + ldsw + _i * 8192), 16, 0, 0); } while (0)
#define PG8_LDA(dst, b, h) do { _Pragma("unroll") for (int m = 0; m < 4; ++m) _Pragma("unroll") for (int k = 0; k < 2; ++k) dst[m][k] = *(const LAS bf16x8*)(lds + PG8_SA(b, h) + aoff + m * 2048 + k * 1024); } while (0)
#define PG8_LDB(dst, b, h) do { _Pragma("unroll") for (int n = 0; n < 2; ++n) _Pragma("unroll") for (int k = 0; k < 2; ++k) dst[n][k] = *(const LAS bf16x8*)(lds + PG8_SB(b, h) + boff + n * 2048 + k * 1024); } while (0)
#define PG8_MMA(ai, bj, At, Bt) do { __builtin_amdgcn_s_setprio(1); _Pragma("unroll") for (int m = 0; m < 4; ++m) _Pragma("unroll") for (int n = 0; n < 2; ++n) _Pragma("unroll") for (int k = 0; k < 2; ++k) \
        acc[ai][bj][m][n] = __builtin_amdgcn_mfma_f32_16x16x32_bf16(Bt[n][k], At[m][k], acc[ai][bj][m][n], 0, 0, 0); __builtin_amdgcn_s_setprio(0); } while (0)
#define PG8_WAIT_V(n) asm volatile("s_waitcnt vmcnt(" #n ")" ::: "memory")
#define PG8_WAIT_L(n) asm volatile("s_waitcnt lgkmcnt(" #n ")" ::: "memory")
#define PG8_BAR __builtin_amdgcn_s_barrier()
#define PG8_SCHED __builtin_amdgcn_sched_barrier(0)
    Unit cur, nxt; int ui = 0;
    if (!S.next(0, cur)) return;
    f32x4 acc[2][2][4][2];
#pragma unroll
    for (int a = 0; a < 2; ++a)
#pragma unroll
        for (int b = 0; b < 2; ++b)
#pragma unroll
            for (int m = 0; m < 4; ++m)
#pragma unroll
                for (int n = 0; n < 2; ++n) acc[a][b][m][n] = (f32x4){0.f, 0.f, 0.f, 0.f};
    bf16x8 At[4][2], B0[2][2], B1[2][2];
    const char* cA = (const char*)(g.A + (size_t)cur.pm * g.a_pm + (size_t)cur.pn * g.a_pn); const char* cB = (const char*)(g.Bt + (size_t)cur.pm * g.b_pm + (size_t)cur.pn * g.b_pn);
    PG8_STAGE(PG8_SB(0, 0), cB, voffB); PG8_STAGE(PG8_SB(0, 1), cB + hstepB, voffB); PG8_STAGE(PG8_SA(0, 0), cA, voffA); PG8_STAGE(PG8_SA(0, 1), cA + hstepA, voffA);
    if (wr == 1) PG8_BAR;
    PG8_WAIT_V(2); PG8_BAR;
    PG8_STAGE(PG8_SB(1, 0), cB + kstep, voffB); PG8_STAGE(PG8_SA(1, 0), cA + kstep, voffA); PG8_STAGE(PG8_SB(1, 1), cB + hstepB + kstep, voffB);
    PG8_WAIT_V(6); PG8_BAR;
    for (;;) {
        const bool has_next = S.next(ui + 1, nxt);
        const char* nA = has_next ? (const char*)(g.A + (size_t)nxt.pm * g.a_pm + (size_t)nxt.pn * g.a_pn) : cA;
        const char* nB = has_next ? (const char*)(g.Bt + (size_t)nxt.pm * g.b_pm + (size_t)nxt.pn * g.b_pn) : cB;
        for (int t = 0; t < nt; t += 2) {
            const bool last = (t == nt - 2);
            const char* a1 = cA + (size_t)(t + 1) * kstep;
            const char* a2 = last ? nA : cA + (size_t)(t + 2) * kstep; const char* b2 = last ? nB : cB + (size_t)(t + 2) * kstep;
            const char* a3 = a2 + kstep; const char* b3 = b2 + kstep;
            PG8_LDB(B0, 0, 0); PG8_LDB(B1, 0, 1); PG8_SCHED; PG8_LDA(At, 0, 0); PG8_STAGE(PG8_SA(1, 1), a1 + hstepA, voffA);
            PG8_WAIT_V(8); PG8_WAIT_L(0); PG8_BAR; PG8_MMA(0, 0, At, B0); PG8_MMA(0, 1, At, B1); PG8_BAR; PG8_SCHED;
            PG8_LDA(At, 0, 1); PG8_STAGE(PG8_SB(0, 0), b2, voffB); PG8_STAGE(PG8_SB(0, 1), b2 + hstepB, voffB); PG8_STAGE(PG8_SA(0, 0), a2, voffA);
            PG8_WAIT_V(8); PG8_WAIT_L(0); PG8_BAR; PG8_MMA(1, 0, At, B0); PG8_MMA(1, 1, At, B1); PG8_BAR; PG8_SCHED;
            PG8_LDB(B0, 1, 0); PG8_LDB(B1, 1, 1); PG8_SCHED; PG8_LDA(At, 1, 0); PG8_STAGE(PG8_SA(0, 1), a2 + hstepA, voffA);
            PG8_WAIT_V(8); PG8_WAIT_L(0); PG8_BAR; PG8_MMA(0, 0, At, B0); PG8_MMA(0, 1, At, B1); PG8_BAR; PG8_SCHED;
            PG8_LDA(At, 1, 1); PG8_STAGE(PG8_SB(1, 0), b3, voffB); PG8_STAGE(PG8_SB(1, 1), b3 + hstepB, voffB); PG8_STAGE(PG8_SA(1, 0), a3, voffA);
            PG8_WAIT_V(8); PG8_WAIT_L(0); PG8_BAR; PG8_MMA(1, 0, At, B0); PG8_MMA(1, 1, At, B1); PG8_BAR; PG8_SCHED;
        }
        if (wr == 0) PG8_BAR;
        E(acc, cur, wr, wc, fr, fq);
        if (!has_next) break;
#pragma unroll
        for (int a = 0; a < 2; ++a)
#pragma unroll
            for (int b = 0; b < 2; ++b)
#pragma unroll
                for (int m = 0; m < 4; ++m)
#pragma unroll
                    for (int n = 0; n < 2; ++n) acc[a][b][m][n] = (f32x4){0.f, 0.f, 0.f, 0.f};
        cur = nxt; cA = nA; cB = nB; ++ui;
        if (wr == 1) PG8_BAR;
    }
    PG8_WAIT_V(0);
    PG8_BAR;
#undef PG8_SA
#undef PG8_SB
#undef PG8_STAGE
#undef PG8_LDA
#undef PG8_LDB
#undef PG8_MMA
#undef PG8_WAIT_V
#undef PG8_WAIT_L
#undef PG8_BAR
#undef PG8_SCHED
}

__device__ __forceinline__ void tr_cvt(LAS unsigned char* lds, const int tid, const float* src, int K, int N, int ld_src, bf16_t* dst, int ldd, int rm, int& base) {
    LAS float* T = (LAS float*)lds;
    const int G = gridDim.x;
    const int tk = K / 64, tn = N / 64, ntiles = tk * tn;
    const int t0 = (int)((blockIdx.x + G - (base % G)) % G);
    for (int t = t0; t < ntiles; t += G) {
        const int kt = t / tn, ntile = t % tn; const int k0 = kt * 64, n0 = ntile * 64;
        __syncthreads();
#pragma unroll
        for (int i = 0; i < 2; ++i) { const int kk = (tid >> 4) + i * 32, n4 = (tid & 15) * 4;
            const f32x4 v = *(const f32x4*)(src + (size_t)(k0 + kk) * ld_src + n0 + n4);
            T[kk * 65 + n4 + 0] = v[0]; T[kk * 65 + n4 + 1] = v[1]; T[kk * 65 + n4 + 2] = v[2]; T[kk * 65 + n4 + 3] = v[3]; }
        __syncthreads();
        { const int n = tid >> 3, k8 = (tid & 7) * 8; float f[8];
#pragma unroll
          for (int j = 0; j < 8; ++j) f[j] = T[(k8 + j) * 65 + n];
          u32x4 w; w.x = cvt_pk_bf16(f[0], f[1]); w.y = cvt_pk_bf16(f[2], f[3]); w.z = cvt_pk_bf16(f[4], f[5]); w.w = cvt_pk_bf16(f[6], f[7]);
          const int nn = n0 + n; const int drow = rm == 0 ? nn : ((nn >> 7) * 256 + (nn & 127) + (rm == 2 ? 128 : 0));
          *(u32x4*)(dst + (size_t)drow * ldd + k0 + k8) = w; }
    }
    base += ntiles;
}
__device__ __forceinline__ void build_ws(const int tid, const float* ws_in, bf16_t* dst) {
    const int total = 16 * 256 * 32;
    for (int p = blockIdx.x * NTHREADS + tid; p < total; p += gridDim.x * NTHREADS) {
        const int lg = p / (256 * 32), t = (p / 32) % 256, s8 = (p % 32) * 8; float f[8];
#pragma unroll
        for (int j = 0; j < 8; ++j) { const int s = s8 + j; const bool keep = ((t >> 7) == (s >> 7)) && ((s & 127) <= (t & 127));
            f[j] = keep ? ws_in[(size_t)lg * 16384 + (t & 127) * 128 + (s & 127)] : 0.f; }
        u32x4 w; w.x = cvt_pk_bf16(f[0], f[1]); w.y = cvt_pk_bf16(f[2], f[3]); w.z = cvt_pk_bf16(f[4], f[5]); w.w = cvt_pk_bf16(f[6], f[7]);
        *(u32x4*)(dst + (size_t)lg * 65536 + t * 256 + s8) = w;
    }
}
__device__ __forceinline__ void norm_pass(const int tid, const float* xin, const bf16_t* mo, const float* gpost, const float* gpre, float* xout, bf16_t* hout) {
    const int lane = tid & 63, wid = tid >> 6;
    f32x4 gp[4], gq[4];
#pragma unroll
    for (int i = 0; i < 4; ++i) { gp[i] = mo ? *(const f32x4*)(gpost + i * 256 + lane * 4) : (f32x4){0.f, 0.f, 0.f, 0.f}; gq[i] = hout ? *(const f32x4*)(gpre + i * 256 + lane * 4) : (f32x4){0.f, 0.f, 0.f, 0.f}; }
    for (int row = blockIdx.x * 8 + wid; row < MTOK; row += gridDim.x * 8) {
        f32x4 x[4];
#pragma unroll
        for (int i = 0; i < 4; ++i) x[i] = *(const f32x4*)(xin + (size_t)row * DM + i * 256 + lane * 4);
        if (mo) {
            f32x4 mv[4]; float q = 0.f;
#pragma unroll
            for (int i = 0; i < 4; ++i) { const u32x2 w = *(const u32x2*)(mo + (size_t)row * DM + i * 256 + lane * 4); mv[i] = (f32x4){bf_lo(w.x), bf_hi(w.x), bf_lo(w.y), bf_hi(w.y)};
                q += (mv[i][0] * mv[i][0] + mv[i][1] * mv[i][1]) + (mv[i][2] * mv[i][2] + mv[i][3] * mv[i][3]); }
#pragma unroll
            for (int o = 32; o >= 1; o >>= 1) q += __shfl_xor(q, o);
            const float rs = 1.0f / sqrtf(q * (1.0f / DM) + EPS);
#pragma unroll
            for (int i = 0; i < 4; ++i) x[i] += mv[i] * rs * gp[i];
        }
        if (xout) {
#pragma unroll
            for (int i = 0; i < 4; ++i) *(f32x4*)(xout + (size_t)row * DM + i * 256 + lane * 4) = x[i];
        }
        if (hout) {
            float q = 0.f;
#pragma unroll
            for (int i = 0; i < 4; ++i) q += (x[i][0] * x[i][0] + x[i][1] * x[i][1]) + (x[i][2] * x[i][2] + x[i][3] * x[i][3]);
#pragma unroll
            for (int o = 32; o >= 1; o >>= 1) q += __shfl_xor(q, o);
            const float rs = 1.0f / sqrtf(q * (1.0f / DM) + EPS);
#pragma unroll
            for (int i = 0; i < 4; ++i) { const f32x4 h = x[i] * rs * gq[i]; u32x2 w; w.x = cvt_pk_bf16(h[0], h[1]); w.y = cvt_pk_bf16(h[2], h[3]);
                *(u32x2*)(hout + (size_t)row * DM + i * 256 + lane * 4) = w; }
        }
    }
}
__device__ __forceinline__ void lnt_pass(LAS unsigned char* lds, const int tid, const bf16_t* V, const float* stats, const float* lg, const float* lb, bf16_t* VnT) {
    LAS unsigned* T = (LAS unsigned*)lds;
    LAS f32x2* MR = (LAS f32x2*)(lds + 32768);
    for (int strip = blockIdx.x; strip < MTOK / 128; strip += gridDim.x) {
        const int t0 = strip * 128;
        __syncthreads();
        if (tid < 128) { const f32x4* sp = (const f32x4*)(stats + (size_t)(t0 + tid) * 64); float s = 0.f, q = 0.f;
#pragma unroll
            for (int i = 0; i < 16; ++i) { const f32x4 v = sp[i]; s += v[0] + v[2]; q += v[1] + v[3]; }
            const float mean = s * (1.0f / AW); const float var = fmaxf(q * (1.0f / AW) - mean * mean, 0.f);
            MR[tid] = (f32x2){mean, 1.0f / sqrtf(var + EPS)}; }
        __syncthreads();
        for (int ct = 0; ct < AW / 128; ++ct) {
            const int c0 = ct * 128;
#pragma unroll
            for (int i = 0; i < 2; ++i) { const int o = tid + i * 512, c8i = o & 15, rp = o >> 4; const int c = c0 + c8i * 8;
                const u32x4 r0 = *(const u32x4*)(V + (size_t)(t0 + 2 * rp) * AW + c), r1 = *(const u32x4*)(V + (size_t)(t0 + 2 * rp + 1) * AW + c);
                const f32x4 g0 = *(const f32x4*)(lg + c), g1 = *(const f32x4*)(lg + c + 4), b0 = *(const f32x4*)(lb + c), b1 = *(const f32x4*)(lb + c + 4);
                const f32x2 m0 = MR[2 * rp], m1 = MR[2 * rp + 1];
                const unsigned ra[4] = {r0.x, r0.y, r0.z, r0.w}, rb[4] = {r1.x, r1.y, r1.z, r1.w};
                const float gg[8] = {g0[0], g0[1], g0[2], g0[3], g1[0], g1[1], g1[2], g1[3]}, bb[8] = {b0[0], b0[1], b0[2], b0[3], b1[0], b1[1], b1[2], b1[3]};
                const int pcol = (rp + 4 * c8i) & 63;
#pragma unroll
                for (int j = 0; j < 4; ++j) {
                    const float a_lo = (bf_lo(ra[j]) - m0.x) * m0.y * gg[2 * j] + bb[2 * j], a_hi = (bf_hi(ra[j]) - m0.x) * m0.y * gg[2 * j + 1] + bb[2 * j + 1];
                    const float b_lo = (bf_lo(rb[j]) - m1.x) * m1.y * gg[2 * j] + bb[2 * j], b_hi = (bf_hi(rb[j]) - m1.x) * m1.y * gg[2 * j + 1] + bb[2 * j + 1];
                    T[(c8i * 8 + 2 * j) * 64 + pcol] = cvt_pk_bf16(a_lo, b_lo);
                    T[(c8i * 8 + 2 * j + 1) * 64 + pcol] = cvt_pk_bf16(a_hi, b_hi);
                } }
            __syncthreads();
#pragma unroll
            for (int i = 0; i < 4; ++i) { const int o = tid + i * 512, cl = o >> 4, q = o & 15; const int ph = (4 * q + 4 * (cl >> 3)) & 63;
                const u32x4 w = *(const LAS u32x4*)(T + cl * 64 + ph);
                *(u32x4*)(VnT + (size_t)(c0 + cl) * MTOK + t0 + 8 * q) = w; }
            __syncthreads();
        }
    }
}
__device__ __forceinline__ void pool_pass(const int tid, const float* P, bf16_t* O) {
    const size_t total = (size_t)MTOK * 256;
    for (size_t idx = (size_t)blockIdx.x * NTHREADS + tid; idx < total; idx += (size_t)gridDim.x * NTHREADS) {
        const int t = (int)(idx >> 8), c4 = (int)(idx & 255) * 4; const int win = 2 << (c4 >> 8); const int tin = t & (SEQ - 1); const int cnt = (tin + 1) < win ? (tin + 1) : win;
        const float* p = P + (size_t)t * DM + c4; const f32x4 self = *(const f32x4*)p; f32x4 s = self;
        for (int j = 1; j < cnt; ++j) s += *(const f32x4*)(p - (size_t)j * DM);
        const float inv = 1.0f / (float)cnt; const f32x4 r = s * inv - self;
        u32x2 w; w.x = cvt_pk_bf16(r[0], r[1]); w.y = cvt_pk_bf16(r[2], r[3]); *(u32x2*)(O + (size_t)t * DM + c4) = w;
    }
}

#define XB_TMO      128
#define XB_XCNT(j)  (256  + 64 * (j))
#define XB_XSUB(j)  (1280 + 64 * (j))
#define XB_XGEN(j)  (2304 + 64 * (j))
#define XB_TOP      3328
#define XB_TOPGEN   3392
#define XCD_BAR_WORDS 3456
#define XB_SPIN_CAP (1u << 18)
__device__ __forceinline__ unsigned xb_ld(unsigned* p)              { return __hip_atomic_load(p, __ATOMIC_RELAXED, __HIP_MEMORY_SCOPE_AGENT); }
__device__ __forceinline__ unsigned xb_add(unsigned* p, unsigned v) { return __hip_atomic_fetch_add(p, v, __ATOMIC_RELAXED, __HIP_MEMORY_SCOPE_AGENT); }
__device__ __forceinline__ unsigned xb_xcc_id() { return (unsigned)__builtin_amdgcn_s_getreg((3 << 11) | 20) & 0xFu; }
#define XB_SPIN(cond, bar) do { unsigned _sp = 0; while (cond) { __builtin_amdgcn_s_sleep(1); \
    if ((++_sp & 255u) == 0u) { if (xb_ld(&(bar)[XB_TMO])) break; if (_sp > XB_SPIN_CAP) { atomicAdd(&(bar)[XB_TMO], 1u); break; } } } } while (0)
struct XcdBarrier { unsigned* bar; unsigned x; volatile LAS unsigned* st; };
__device__ __forceinline__ XcdBarrier xcd_barrier_post(unsigned* bar, volatile LAS unsigned* st) {
    XcdBarrier b; b.bar = bar; b.x = xb_xcc_id(); b.st = st;
    if (threadIdx.x == 0) (void)xb_add(&bar[XB_XCNT(b.x)], 1u);
    return b;
}
__device__ __forceinline__ void xcd_barrier_complete(unsigned* bar, unsigned x, unsigned& nloc, unsigned& nx) {
    const unsigned G = gridDim.x * gridDim.y * gridDim.z;
    unsigned sum, cnt, mine, sp = 0u;
    for (;;) {
        sum = 0u; cnt = 0u; mine = 0u;
#pragma unroll
        for (unsigned j = 0; j < 16; ++j) { const unsigned c = xb_ld(&bar[XB_XCNT(j)]); sum += c; cnt += (c > 0u) ? 1u : 0u; mine = (j == x) ? c : mine; }
        if (sum == G) break;
        __builtin_amdgcn_s_sleep(1);
        if ((++sp & 255u) == 0u) { if (xb_ld(&bar[XB_TMO])) break; if (sp > XB_SPIN_CAP) { atomicAdd(&bar[XB_TMO], 1u); break; } }
    }
    nloc = mine > 0u ? mine : 1u; nx = cnt > 0u ? cnt : 1u;
}
__device__ __forceinline__ void xcd_barrier(const XcdBarrier& b) {
    asm volatile("s_waitcnt vmcnt(0)" ::: "memory");
    __syncthreads();
    if (threadIdx.x == 0) {
        unsigned* bar = b.bar;
        __builtin_amdgcn_s_waitcnt(0);
        unsigned nloc = b.st[0], nx = b.st[1];
        if (nloc == 0u) { xcd_barrier_complete(bar, b.x, nloc, nx); b.st[0] = nloc; b.st[1] = nx; }
        const unsigned old = xb_add(&bar[XB_XSUB(b.x)], 1u);
        const unsigned gen = old / nloc;
        if (old + 1u == (gen + 1u) * nloc) {
            __builtin_amdgcn_fence(__ATOMIC_RELEASE, "agent");
            asm volatile("s_waitcnt vmcnt(0)" ::: "memory");
            const unsigned og = xb_add(&bar[XB_TOP], 1u);
            const unsigned tg = og / nx;
            if (og + 1u == (tg + 1u) * nx) xb_add(&bar[XB_TOPGEN], 1u);
            else XB_SPIN(xb_ld(&bar[XB_TOPGEN]) == tg, bar);
            __builtin_amdgcn_fence(__ATOMIC_ACQUIRE, "agent");
            xb_add(&bar[XB_XGEN(b.x)], 1u);
            asm volatile("s_waitcnt vmcnt(0)" ::: "memory");
        } else {
            XB_SPIN(xb_ld(&bar[XB_XGEN(b.x)]) == gen, bar);
            __builtin_amdgcn_fence(__ATOMIC_ACQUIRE, "agent");
            asm volatile("s_waitcnt vmcnt(0)" ::: "memory");
        }
    }
    __syncthreads();
}

struct Args { const float* in[18]; float* out; unsigned char* ws; int ph_lo, ph_hi; };
constexpr int N_PHASES = 1 + DEPTH * 8;

__global__ void __launch_bounds__(NTHREADS, 2) fwd_mega(Args a) {
    extern __shared__ __attribute__((aligned(16))) unsigned char lds_raw[];
    LAS unsigned char* lds = (LAS unsigned char*)lds_raw;
    cg::grid_group grid = cg::this_grid();
    unsigned char* ws = a.ws;
    const float* x_in = a.in[0];
    bf16_t* U = (bf16_t*)(ws + WS_R1); float* P = (float*)(ws + WS_R1); bf16_t* ACT = (bf16_t*)(ws + WS_R1);
    bf16_t* V = (bf16_t*)(ws + WS_R2); bf16_t* GT = (bf16_t*)(ws + WS_R2); bf16_t* POOL = (bf16_t*)(ws + WS_R2); bf16_t* MIX = (bf16_t*)(ws + WS_R2 + 64 * MiB);
    bf16_t* H = (bf16_t*)(ws + WS_R3); bf16_t* MO = (bf16_t*)(ws + WS_R3 + 64 * MiB); bf16_t* VNT = (bf16_t*)(ws + WS_R3);
    float* STATS = (float*)(ws + WS_STATS);
    const int G = gridDim.x, bid = blockIdx.x;
    volatile LAS unsigned* bst = (volatile LAS unsigned*)(lds + STAGE_BYTES);
    if (threadIdx.x < 16) bst[threadIdx.x] = 0u;
    __syncthreads();
    XcdBarrier bar; bar.bar = (unsigned*)(ws + WS_BAR); bar.x = 0; bar.st = bst;
    if (a.ph_hi - a.ph_lo > 1) bar = xcd_barrier_post((unsigned*)(ws + WS_BAR), bst);

    for (int ph = a.ph_lo; ph < a.ph_hi; ++ph) {
        int tid = threadIdx.x; asm volatile("" : "+v"(tid));
        if (ph == 0 && (PHMASK & 1)) {
            int base = 0;
            for (int j = 0; j < 2; ++j) {
                tr_cvt(lds, tid, a.in[1] + (size_t)j * DM * 4096, DM, 4096, 4096, (bf16_t*)(ws + WS_AWIN) + (size_t)j * 4096 * DM, DM, 0, base);
                tr_cvt(lds, tid, a.in[6] + (size_t)j * AW * DM, AW, DM, DM, (bf16_t*)(ws + WS_AWOUT) + (size_t)j * DM * AW, AW, 0, base);
                tr_cvt(lds, tid, a.in[7] + (size_t)j * DM * DM, DM, DM, DM, (bf16_t*)(ws + WS_BWIN) + (size_t)j * DM * DM, DM, 0, base);
                for (int g = 0; g < 4; ++g) tr_cvt(lds, tid, a.in[8] + (size_t)(j * 4 + g) * 65536, 256, 256, 256, (bf16_t*)(ws + WS_BWGRP) + (size_t)(j * 4 + g) * 65536, 256, 0, base);
                tr_cvt(lds, tid, a.in[10] + (size_t)j * DM * DM, DM, DM, DM, (bf16_t*)(ws + WS_BWOUT) + (size_t)j * DM * DM, DM, 0, base);
            }
            for (int i = 0; i < DEPTH; ++i) {
                tr_cvt(lds, tid, a.in[15] + (size_t)i * DM * DFF, DM, DFF, DFF, (bf16_t*)(ws + WS_FGU) + (size_t)i * 2 * DFF * DM, DM, 1, base);
                tr_cvt(lds, tid, a.in[16] + (size_t)i * DM * DFF, DM, DFF, DFF, (bf16_t*)(ws + WS_FGU) + (size_t)i * 2 * DFF * DM, DM, 2, base);
                tr_cvt(lds, tid, a.in[17] + (size_t)i * DFF * DM, DFF, DM, DM, (bf16_t*)(ws + WS_FDN) + (size_t)i * DM * DFF, DFF, 0, base);
            }
            build_ws(tid, a.in[4], (bf16_t*)(ws + WS_AWS));
            norm_pass(tid, x_in, nullptr, nullptr, a.in[11], nullptr, H);
        } else {
            const int li = (ph - 1) >> 3, st = (ph - 1) & 7, j = li >> 1; const bool isB = li & 1;
            if (st == 0) {
                if (!isB && (PHMASK & 2)) {
                    Gemm g{H, (const bf16_t*)(ws + WS_AWIN) + (size_t)j * 4096 * DM, DM, DM, DM, (long)BM * DM, 0, 0, (long)BM * DM};
                    StaticOrder S; S.init(MTOK / BM, 4096 / BM, G, bid); EpiGeluUV E{U, V, STATS};
                    gemm_phase(lds, tid, g, S, E);
                } else if (isB && (PHMASK & 4)) {
                    Gemm g{H, (const bf16_t*)(ws + WS_BWIN) + (size_t)j * DM * DM, DM, DM, DM, (long)BM * DM, 0, 0, (long)BM * DM};
                    StaticOrder S; S.init(MTOK / BM, DM / BM, G, bid); EpiF32 E{P, DM};
                    gemm_phase(lds, tid, g, S, E);
                }
            } else if (st == 1) {
                if (!isB && (PHMASK & 8)) lnt_pass(lds, tid, V, STATS, a.in[2] + j * AW, a.in[3] + j * AW, VNT);
                else if (isB && (PHMASK & 16)) pool_pass(tid, P, POOL);
            } else if (st == 2) {
                if (!isB && (PHMASK & 32)) {
                    Gemm g{(const bf16_t*)(ws + WS_AWS) + (size_t)j * 8 * 65536, VNT, 256, MTOK, 256, 0, 65536, 256, (long)256 * MTOK};
                    StaticOrder S; S.init(MTOK / BM, 8, G, bid); EpiGate E{U, GT, a.in[5] + j * 8 * 128};
                    gemm_phase(lds, tid, g, S, E);
                } else if (isB && (PHMASK & 64)) {
                    Gemm g{POOL, (const bf16_t*)(ws + WS_BWGRP) + (size_t)j * 4 * 65536, DM, 256, 256, (long)BM * DM, 256, 0, 65536};
                    StaticOrder S; S.init(MTOK / BM, 4, G, bid); EpiBf16S E{MIX, DM, a.in[9] + j * DM};
                    gemm_phase(lds, tid, g, S, E);
                }
            } else if ((st == 3 || st == 6) && (PHMASK & 128)) {
                Gemm g;
                if (st == 6) g = Gemm{ACT, (const bf16_t*)(ws + WS_FDN) + (size_t)li * DM * DFF, DFF, DFF, DFF, (long)BM * DFF, 0, 0, (long)BM * DFF};
                else if (!isB) g = Gemm{GT, (const bf16_t*)(ws + WS_AWOUT) + (size_t)j * DM * AW, AW, AW, AW, (long)BM * AW, 0, 0, (long)BM * AW};
                else g = Gemm{MIX, (const bf16_t*)(ws + WS_BWOUT) + (size_t)j * DM * DM, DM, DM, DM, (long)BM * DM, 0, 0, (long)BM * DM};
                StaticOrder S; S.init(MTOK / BM, DM / BM, G, bid); EpiBf16S E{MO, DM, nullptr};
                gemm_phase(lds, tid, g, S, E);
            } else if (st == 4 && (PHMASK & 256)) {
                norm_pass(tid, li == 0 ? x_in : a.out, MO, a.in[12] + li * DM, a.in[13] + li * DM, a.out, H);
            } else if (st == 5 && (PHMASK & 512)) {
                Gemm g{H, (const bf16_t*)(ws + WS_FGU) + (size_t)li * 2 * DFF * DM, DM, DM, DM, (long)BM * DM, 0, 0, (long)BM * DM};
                StaticOrder S; S.init(MTOK / BM, 2 * DFF / BM, G, bid); EpiSwiGLU E{ACT};
                gemm_phase(lds, tid, g, S, E);
            } else if (st == 7 && (PHMASK & 1024)) {
                const bool lastl = (li == DEPTH - 1);
                norm_pass(tid, a.out, MO, a.in[14] + li * DM, lastl ? a.in[11] : a.in[11] + (li + 1) * DM, a.out, lastl ? nullptr : H);
            }
        }
        if (ph + 1 < a.ph_hi) { if (ph == 0) grid.sync(); else xcd_barrier(bar); }
    }
}

extern "C" void kernel_launch(void* const* d_in, const int* in_sizes, int n_in, void* d_out, int out_size, void* d_ws, size_t ws_size, hipStream_t stream) {
    static int grid = 0;
    if (grid == 0) {
        if (n_in != 18 || ws_size < WS_END) { fprintf(stderr, "kernel_launch: unexpected n_in %d / ws %zu\n", n_in, ws_size); grid = -1; return; }
        int dev = 0, cus = 0, per_cu = 0;
        hipGetDevice(&dev); hipDeviceGetAttribute(&cus, hipDeviceAttributeMultiprocessorCount, dev);
        if (hipFuncSetAttribute((const void*)fwd_mega, hipFuncAttributeMaxDynamicSharedMemorySize, LDS_BYTES) != hipSuccess) { fprintf(stderr, "kernel_launch: hipFuncSetAttribute failed\n"); grid = -1; return; }
        if (hipOccupancyMaxActiveBlocksPerMultiprocessor(&per_cu, (const void*)fwd_mega, NTHREADS, LDS_BYTES) != hipSuccess || per_cu < 1) { fprintf(stderr, "kernel_launch: occupancy query says %d\n", per_cu); per_cu = 1; }
        (void)hipGetLastError();
        grid = cus;
    }
    if (grid < 0) return;
    Args a{};
    for (int i = 0; i < 18; ++i) a.in[i] = (const float*)d_in[i];
    a.out = (float*)d_out; a.ws = (unsigned char*)d_ws;
#if N_LAUNCH_MODE == 1
    for (int ph = 0; ph < N_PHASES; ++ph) { a.ph_lo = ph; a.ph_hi = ph + 1; hipLaunchKernelGGL(fwd_mega, dim3(grid), dim3(NTHREADS), LDS_BYTES, stream, a); }
#else
    a.ph_lo = 0; a.ph_hi = N_PHASES;
    if (hipMemsetAsync((char*)d_ws + WS_BAR, 0, XCD_BAR_WORDS * sizeof(unsigned), stream) != hipSuccess) { fprintf(stderr, "memset failed\n"); return; }
    void* args[] = {&a};
    hipError_t e = hipLaunchCooperativeKernel((const void*)fwd_mega, dim3(grid), dim3(NTHREADS), args, LDS_BYTES, stream);
    if (e != hipSuccess) fprintf(stderr, "cooperative launch failed: %s (grid %d)\n", hipGetErrorString(e), grid);
#endif
}
```

```cpp
#include <hip/hip_runtime.h>
#include <hip/hip_cooperative_groups.h>
#include <cstdio>
namespace cg = cooperative_groups;

#ifndef N_LAUNCH_MODE
#define N_LAUNCH_MODE 0
#endif

#ifndef PHMASK
#define PHMASK 0xFFFF
#endif
#define LAS __attribute__((address_space(3)))
typedef unsigned short bf16_t;
typedef short bf16x8 __attribute__((ext_vector_type(8)));
typedef float f32x4 __attribute__((ext_vector_type(4)));
typedef float f32x2 __attribute__((ext_vector_type(2)));
typedef unsigned u32x4 __attribute__((ext_vector_type(4)));
typedef unsigned u32x2 __attribute__((ext_vector_type(2)));

constexpr int MTOK = 32768, DM = 1024, SEQ = 8192, AW = 2048, DFF = 2816, DEPTH = 4;
constexpr float EPS = 1e-6f;
constexpr int BM = 256, BK = 64, HALF = 128, HTB = HALF * BK * 2, STAGE_BYTES = 8 * HTB, NXCD = 8, WGM = 8;
constexpr int LDS_BYTES = STAGE_BYTES + 64;
constexpr int NTHREADS = 512;

constexpr size_t MiB = 1024 * 1024;
constexpr size_t WS_AWIN = 0;
constexpr size_t WS_AWOUT = 16 * MiB;
constexpr size_t WS_AWS = 24 * MiB;
constexpr size_t WS_BWIN = 26 * MiB;
constexpr size_t WS_BWGRP = 30 * MiB;
constexpr size_t WS_BWOUT = 31 * MiB;
constexpr size_t WS_FGU = 35 * MiB;
constexpr size_t WS_FDN = 79 * MiB;
constexpr size_t WS_STATS = 101 * MiB;
constexpr size_t WS_BAR = 110 * MiB;
constexpr size_t WS_R1 = 112 * MiB;
constexpr size_t WS_R2 = 240 * MiB;
constexpr size_t WS_R3 = 368 * MiB;
constexpr size_t WS_END = 496 * MiB;

__device__ __forceinline__ unsigned cvt_pk_bf16(float lo, float hi) { unsigned r; asm volatile("v_cvt_pk_bf16_f32 %0, %1, %2" : "=v"(r) : "v"(lo), "v"(hi)); return r; }
__device__ __forceinline__ float bf_lo(unsigned w) { return __uint_as_float(w << 16); }
__device__ __forceinline__ float bf_hi(unsigned w) { return __uint_as_float(w & 0xffff0000u); }

__device__ __forceinline__ int lds_byte(int r, int c) { const int st = (r >> 4) * 2 + (c >> 5), rr = r & 15, cc = c & 31, ob = rr * 64 + cc * 2; return st * 1024 + (ob ^ (((ob >> 9) & 1) << 5)); }
__device__ __forceinline__ void stage_rc(int b, int& R, int& C) { const int st = b / 1024, sb = b % 1024, swz = sb ^ (((sb >> 9) & 1) << 5); R = (st >> 1) * 16 + swz / 64; C = (st & 1) * 32 + (swz % 64) / 2; }
__device__ __forceinline__ int perm32(int rho) { const int n = rho >> 4, i = rho & 15; return 8 * (i >> 2) + 4 * n + (i & 3); }

struct Unit { int pm, pn; };
struct Gemm { const bf16_t* A; const bf16_t* Bt; int lda, ldb, K; long a_pm, a_pn, b_pm, b_pn; };

struct StaticOrder {
    int nM, nN, nwg, G, c;
    __device__ void init(int nM_, int nN_, int G_, int c_) { nM = nM_; nN = nN_; nwg = nM * nN; G = G_; c = c_; }
    __device__ bool next(int i, Unit& u) const {
        const long L = (long)i * G + c; if (L >= nwg) return false;
        int wgid = (int)L; { const int q = nwg / NXCD, r = nwg % NXCD, xcd = wgid % NXCD, off = wgid / NXCD; wgid = (xcd < r ? xcd * (q + 1) : r * (q + 1) + (xcd - r) * q) + off; }
        const int nig = WGM * nN, gid = wgid / nig, fm = gid * WGM, gsz = (nM - fm) < WGM ? (nM - fm) : WGM;
        u.pm = fm + ((wgid % nig) % gsz); u.pn = (wgid % nig) / gsz; return true;
    }
};

__device__ __forceinline__ f32x2 gelu_pk(f32x2 v) {
    const f32x2 av = __builtin_elementwise_abs(v), d = av * 0.2316418882f + 1.0f;
    f32x2 t; t.x = __builtin_amdgcn_rcpf(d.x); t.y = __builtin_amdgcn_rcpf(d.y);
    f32x2 q = t * 0.5307027145f + (-0.7265760135f); q = q * t + 0.7107068705f; q = q * t + (-0.142248368f); q = q * t + 0.127414796f; q = q * t;
    const f32x2 s = (v * v) * (-0.72134752044f);
    f32x2 e; e.x = __builtin_amdgcn_exp2f(s.x); e.y = __builtin_amdgcn_exp2f(s.y);
    const f32x2 m = v * (q * e), r = v - m;
    f32x2 o; o.x = v.x < 0.f ? m.x : r.x; o.y = v.y < 0.f ? m.y : r.y; return o;
}
__device__ __forceinline__ float silu_f(float x) { return x * __builtin_amdgcn_rcpf(1.0f + __builtin_amdgcn_exp2f(x * -1.44269504089f)); }

struct EpiGeluUV {
    static constexpr bool PERM = true;
    bf16_t* U; bf16_t* V; float* stats;
    __device__ __forceinline__ void operator()(const f32x4 (&acc)[2][2][4][2], const Unit& u, int wr, int wc, int fr, int fq) const {
        const int row0 = u.pm * BM + wr * 64 + fr; const bool isV = u.pn >= 8; const int colt = (u.pn & 7) * BM;
        bf16_t* base = isV ? V : U; const int col0 = colt + wc * 32 + 8 * fq;
#pragma unroll
        for (int ai = 0; ai < 2; ++ai)
#pragma unroll
            for (int m = 0; m < 4; ++m) { const int row = row0 + ai * HALF + m * 16; bf16_t* rowp = base + (size_t)row * AW + col0; float s = 0.f, q = 0.f;
#pragma unroll
                for (int bj = 0; bj < 2; ++bj) { const f32x4 v0 = acc[ai][bj][m][0], v1 = acc[ai][bj][m][1];
                    const f32x2 a = gelu_pk((f32x2){v0[0], v0[1]}), b = gelu_pk((f32x2){v0[2], v0[3]}), c = gelu_pk((f32x2){v1[0], v1[1]}), d = gelu_pk((f32x2){v1[2], v1[3]});
                    s += (a.x + a.y) + (b.x + b.y) + (c.x + c.y) + (d.x + d.y);
                    q += (a.x * a.x + a.y * a.y) + (b.x * b.x + b.y * b.y) + (c.x * c.x + c.y * c.y) + (d.x * d.x + d.y * d.y);
                    u32x4 w; w.x = cvt_pk_bf16(a.x, a.y); w.y = cvt_pk_bf16(b.x, b.y); w.z = cvt_pk_bf16(c.x, c.y); w.w = cvt_pk_bf16(d.x, d.y);
                    *(u32x4*)(rowp + bj * HALF) = w; }
                if (isV) { s += __shfl_xor(s, 16); s += __shfl_xor(s, 32); q += __shfl_xor(q, 16); q += __shfl_xor(q, 32);
                    if (fq == 0) *(f32x2*)(stats + ((size_t)row * 32 + (u.pn - 8) * 4 + wc) * 2) = (f32x2){s, q}; } }
    }
};
struct EpiGate {
    static constexpr bool PERM = true;
    const bf16_t* U; bf16_t* O; const float* bs;
    __device__ __forceinline__ void operator()(const f32x4 (&acc)[2][2][4][2], const Unit& u, int wr, int wc, int fr, int fq) const {
        const int row0 = u.pm * BM + wr * 64 + fr; const int col0 = u.pn * BM + wc * 32 + 8 * fq;
#pragma unroll
        for (int ai = 0; ai < 2; ++ai)
#pragma unroll
            for (int m = 0; m < 4; ++m) { const int row = row0 + ai * HALF + m * 16; const float bias = bs[u.pn * 128 + wr * 64 + m * 16 + fr];
                const size_t off = (size_t)row * AW + col0;
#pragma unroll
                for (int bj = 0; bj < 2; ++bj) { const u32x4 uu = *(const u32x4*)(U + off + bj * HALF); const f32x4 v0 = acc[ai][bj][m][0] + bias, v1 = acc[ai][bj][m][1] + bias;
                    u32x4 w; w.x = cvt_pk_bf16(bf_lo(uu.x) * v0[0], bf_hi(uu.x) * v0[1]); w.y = cvt_pk_bf16(bf_lo(uu.y) * v0[2], bf_hi(uu.y) * v0[3]);
                    w.z = cvt_pk_bf16(bf_lo(uu.z) * v1[0], bf_hi(uu.z) * v1[1]); w.w = cvt_pk_bf16(bf_lo(uu.w) * v1[2], bf_hi(uu.w) * v1[3]);
                    *(u32x4*)(O + off + bj * HALF) = w; } }
    }
};
struct EpiBf16S {
    static constexpr bool PERM = true;
    bf16_t* O; int ldc; const float* scale;
    __device__ __forceinline__ void operator()(const f32x4 (&acc)[2][2][4][2], const Unit& u, int wr, int wc, int fr, int fq) const {
        const int row0 = u.pm * BM + wr * 64 + fr; const int col0 = u.pn * BM + wc * 32 + 8 * fq;
        f32x4 sv[2][2];
#pragma unroll
        for (int bj = 0; bj < 2; ++bj)
#pragma unroll
            for (int n = 0; n < 2; ++n) sv[bj][n] = scale ? *(const f32x4*)(scale + col0 + bj * HALF + 4 * n) : (f32x4){1.f, 1.f, 1.f, 1.f};
#pragma unroll
        for (int ai = 0; ai < 2; ++ai)
#pragma unroll
            for (int m = 0; m < 4; ++m) { bf16_t* rowp = O + (size_t)(row0 + ai * HALF + m * 16) * ldc + col0;
#pragma unroll
                for (int bj = 0; bj < 2; ++bj) { const f32x4 v0 = acc[ai][bj][m][0] * sv[bj][0], v1 = acc[ai][bj][m][1] * sv[bj][1];
                    u32x4 w; w.x = cvt_pk_bf16(v0[0], v0[1]); w.y = cvt_pk_bf16(v0[2], v0[3]); w.z = cvt_pk_bf16(v1[0], v1[1]); w.w = cvt_pk_bf16(v1[2], v1[3]);
                    *(u32x4*)(rowp + bj * HALF) = w; } }
    }
};
struct EpiF32 {
    static constexpr bool PERM = false;
    float* C; int ldc;
    __device__ __forceinline__ void operator()(const f32x4 (&acc)[2][2][4][2], const Unit& u, int wr, int wc, int fr, int fq) const {
        const int row0 = u.pm * BM + wr * 64 + fr, col0 = u.pn * BM + wc * 32 + 4 * fq;
#pragma unroll
        for (int ai = 0; ai < 2; ++ai)
#pragma unroll
            for (int m = 0; m < 4; ++m) { float* rowp = C + (size_t)(row0 + ai * HALF + m * 16) * ldc + col0;
#pragma unroll
                for (int bj = 0; bj < 2; ++bj)
#pragma unroll
                    for (int n = 0; n < 2; ++n) *(f32x4*)(rowp + bj * HALF + n * 16) = acc[ai][bj][m][n]; }
    }
};
struct EpiSwiGLU {
    static constexpr bool PERM = true;
    bf16_t* O;
    __device__ __forceinline__ void operator()(const f32x4 (&acc)[2][2][4][2], const Unit& u, int wr, int wc, int fr, int fq) const {
        const int row0 = u.pm * BM + wr * 64 + fr; const int col0 = u.pn * HALF + wc * 32 + 8 * fq;
#pragma unroll
        for (int ai = 0; ai < 2; ++ai)
#pragma unroll
            for (int m = 0; m < 4; ++m) { bf16_t* rowp = O + (size_t)(row0 + ai * HALF + m * 16) * DFF + col0;
                const f32x4 g0 = acc[ai][0][m][0], g1 = acc[ai][0][m][1], u0 = acc[ai][1][m][0], u1 = acc[ai][1][m][1];
                u32x4 w; w.x = cvt_pk_bf16(silu_f(g0[0]) * u0[0], silu_f(g0[1]) * u0[1]); w.y = cvt_pk_bf16(silu_f(g0[2]) * u0[2], silu_f(g0[3]) * u0[3]);
                w.z = cvt_pk_bf16(silu_f(g1[0]) * u1[0], silu_f(g1[1]) * u1[1]); w.w = cvt_pk_bf16(silu_f(g1[2]) * u1[2], silu_f(g1[3]) * u1[3]);
                *(u32x4*)rowp = w; }
    }
};

template <class Epi>
__device__ __forceinline__ void gemm_phase(LAS unsigned char* lds, const int tid, const Gemm g, const StaticOrder& S, const Epi& E) {
    const int wid = __builtin_amdgcn_readfirstlane(tid >> 6), lane = tid & 63, wr = wid >> 2, wc = wid & 3, fr = lane & 15, fq = lane >> 4;
    int K = g.K; asm volatile("" : "+s"(K)); const int nt = K / BK;
    unsigned voffA[2], voffB[2];
#pragma unroll
    for (int i = 0; i < 2; ++i) { int R, C; stage_rc(tid * 16 + i * 8192, R, C); const int Rb = Epi::PERM ? ((R & ~31) + perm32(R & 31)) : R;
        voffA[i] = (unsigned)(R * g.lda + C) * 2u; voffB[i] = (unsigned)(Rb * g.ldb + C) * 2u; }
    const size_t kstep = (size_t)(BK * 2);
    const size_t hstepA = (size_t)HALF * g.lda * 2, hstepB = (size_t)HALF * g.ldb * 2;
    const unsigned ldsw = (unsigned)wid * 1024u;
    const int aoff = lds_byte(wr * 64 + fr, fq * 8), boff = lds_byte(wc * 32 + fr, fq * 8);
#define PG8_SA(b, h) (((b) * 2 + (h)) * HTB)
#define PG8_SB(b, h) ((4 + (b) * 2 + (h)) * HTB)
#define PG8_STAGE(bufoff, gbase, voff) do { _Pragma("unroll") for (int _i = 0; _i < 2; ++_i) \
        __builtin_amdgcn_global_load_lds((const unsigned*)((const char*)(gbase) + (voff)[_i]), (LAS unsigned*)(lds + (bufoff) + ldsw + _i * 8192), 16, 0, 0); } while (0)
#define PG8_LDA(dst, b, h) do { _Pragma("unroll") for (int m = 0; m < 4; ++m) _Pragma("unroll") for (int k = 0; k < 2; ++k) dst[m][k] = *(const LAS bf16x8*)(lds + PG8_SA(b, h) + aoff + m * 2048 + k * 1024); } while (0)
#define PG8_LDB(dst, b, h) do { _Pragma("unroll") for (int n = 0; n < 2; ++n) _Pragma("unroll") for (int k = 0; k < 2; ++k) dst[n][k] = *(const LAS bf16x8*)(lds + PG8_SB(b, h) + boff + n * 2048 + k * 1024); } while (0)
#define PG8_MMA(ai, bj, At, Bt) do { __builtin_amdgcn_s_setprio(1); _Pragma("unroll") for (int m = 0; m < 4; ++m) _Pragma("unroll") for (int n = 0; n < 2; ++n) _Pragma("unroll") for (int k = 0; k < 2; ++k) \
        acc[ai][bj][m][n] = __builtin_amdgcn_mfma_f32_16x16x32_bf16(Bt[n][k], At[m][k], acc[ai][bj][m][n], 0, 0, 0); __builtin_amdgcn_s_setprio(0); } while (0)
#define PG8_WAIT_V(n) asm volatile("s_waitcnt vmcnt(" #n ")" ::: "memory")
#define PG8_WAIT_L(n) asm volatile("s_waitcnt lgkmcnt(" #n ")" ::: "memory")
#define PG8_BAR __builtin_amdgcn_s_barrier()
#define PG8_SCHED __builtin_amdgcn_sched_barrier(0)
    Unit cur, nxt; int ui = 0;
    if (!S.next(0, cur)) return;
    f32x4 acc[2][2][4][2];
#pragma unroll
    for (int a = 0; a < 2; ++a)
#pragma unroll
        for (int b = 0; b < 2; ++b)
#pragma unroll
            for (int m = 0; m < 4; ++m)
#pragma unroll
                for (int n = 0; n < 2; ++n) acc[a][b][m][n] = (f32x4){0.f, 0.f, 0.f, 0.f};
    bf16x8 At[4][2], B0[2][2], B1[2][2];
    const char* cA = (const char*)(g.A + (size_t)cur.pm * g.a_pm + (size_t)cur.pn * g.a_pn); const char* cB = (const char*)(g.Bt + (size_t)cur.pm * g.b_pm + (size_t)cur.pn * g.b_pn);
    PG8_STAGE(PG8_SB(0, 0), cB, voffB); PG8_STAGE(PG8_SB(0, 1), cB + hstepB, voffB); PG8_STAGE(PG8_SA(0, 0), cA, voffA); PG8_STAGE(PG8_SA(0, 1), cA + hstepA, voffA);
    if (wr == 1) PG8_BAR;
    PG8_WAIT_V(2); PG8_BAR;
    PG8_STAGE(PG8_SB(1, 0), cB + kstep, voffB); PG8_STAGE(PG8_SA(1, 0), cA + kstep, voffA); PG8_STAGE(PG8_SB(1, 1), cB + hstepB + kstep, voffB);
    PG8_WAIT_V(6); PG8_BAR;
    for (;;) {
        const bool has_next = S.next(ui + 1, nxt);
        const char* nA = has_next ? (const char*)(g.A + (size_t)nxt.pm * g.a_pm + (size_t)nxt.pn * g.a_pn) : cA;
        const char* nB = has_next ? (const char*)(g.Bt + (size_t)nxt.pm * g.b_pm + (size_t)nxt.pn * g.b_pn) : cB;
        for (int t = 0; t < nt; t += 2) {
            const bool last = (t == nt - 2);
            const char* a1 = cA + (size_t)(t + 1) * kstep;
            const char* a2 = last ? nA : cA + (size_t)(t + 2) * kstep; const char* b2 = last ? nB : cB + (size_t)(t + 2) * kstep;
            const char* a3 = a2 + kstep; const char* b3 = b2 + kstep;
            PG8_LDB(B0, 0, 0); PG8_LDB(B1, 0, 1); PG8_SCHED; PG8_LDA(At, 0, 0); PG8_STAGE(PG8_SA(1, 1), a1 + hstepA, voffA);
            PG8_WAIT_V(8); PG8_WAIT_L(0); PG8_BAR; PG8_MMA(0, 0, At, B0); PG8_MMA(0, 1, At, B1); PG8_BAR; PG8_SCHED;
            PG8_LDA(At, 0, 1); PG8_STAGE(PG8_SB(0, 0), b2, voffB); PG8_STAGE(PG8_SB(0, 1), b2 + hstepB, voffB); PG8_STAGE(PG8_SA(0, 0), a2, voffA);
            PG8_WAIT_V(8); PG8_WAIT_L(0); PG8_BAR; PG8_MMA(1, 0, At, B0); PG8_MMA(1, 1, At, B1); PG8_BAR; PG8_SCHED;
            PG8_LDB(B0, 1, 0); PG8_LDB(B1, 1, 1); PG8_SCHED; PG8_LDA(At, 1, 0); PG8_STAGE(PG8_SA(0, 1), a2 + hstepA, voffA);
            PG8_WAIT_V(8); PG8_WAIT_L(0); PG8_BAR; PG8_MMA(0, 0, At, B0); PG8_MMA(0, 1, At, B1); PG8_BAR; PG8_SCHED;
            PG8_LDA(At, 1, 1); PG8_STAGE(PG8_SB(1, 0), b3, voffB); PG8_STAGE(PG8_SB(1, 1), b3 + hstepB, voffB); PG8_STAGE(PG8_SA(1, 0), a3, voffA);
            PG8_WAIT_V(8); PG8_WAIT_L(0); PG8_BAR; PG8_MMA(1, 0, At, B0); PG8_MMA(1, 1, At, B1); PG8_BAR; PG8_SCHED;
        }
        if (wr == 0) PG8_BAR;
        E(acc, cur, wr, wc, fr, fq);
        if (!has_next) break;
#pragma unroll
        for (int a = 0; a < 2; ++a)
#pragma unroll
            for (int b = 0; b < 2; ++b)
#pragma unroll
                for (int m = 0; m < 4; ++m)
#pragma unroll
                    for (int n = 0; n < 2; ++n) acc[a][b][m][n] = (f32x4){0.f, 0.f, 0.f, 0.f};
        cur = nxt; cA = nA; cB = nB; ++ui;
        if (wr == 1) PG8_BAR;
    }
    PG8_WAIT_V(0);
    PG8_BAR;
#undef PG8_SA
#undef PG8_SB
#undef PG8_STAGE
#undef PG8_LDA
#undef PG8_LDB
#undef PG8_MMA
#undef PG8_WAIT_V
#undef PG8_WAIT_L
#undef PG8_BAR
#undef PG8_SCHED
}

__device__ __forceinline__ void tr_cvt(LAS unsigned char* lds, const int tid, const float* src, int K, int N, int ld_src, bf16_t* dst, int ldd, int rm, int& base) {
    LAS float* T = (LAS float*)lds;
    const int G = gridDim.x;
    const int tk = K / 64, tn = N / 256, ntiles = tk * tn;
    const int t0 = (int)((blockIdx.x + G - (base % G)) % G);
    for (int t = t0; t < ntiles; t += G) {
        const int kt = t / tn, ntile = t % tn; const int k0 = kt * 64, n0 = ntile * 256;
        f32x4 v[8];
#pragma unroll
        for (int i = 0; i < 8; ++i) { const int idx = tid + i * 512, kk = idx >> 6, n4 = (idx & 63) * 4; v[i] = *(const f32x4*)(src + (size_t)(k0 + kk) * ld_src + n0 + n4); }
        __syncthreads();
#pragma unroll
        for (int i = 0; i < 8; ++i) { const int idx = tid + i * 512, kk = idx >> 6, n4 = (idx & 63) * 4;
            T[kk * 257 + n4 + 0] = v[i][0]; T[kk * 257 + n4 + 1] = v[i][1]; T[kk * 257 + n4 + 2] = v[i][2]; T[kk * 257 + n4 + 3] = v[i][3]; }
        __syncthreads();
#pragma unroll
        for (int i = 0; i < 4; ++i) { const int idx = tid + i * 512, n = idx >> 3, k8 = (idx & 7) * 8; float f[8];
#pragma unroll
          for (int j = 0; j < 8; ++j) f[j] = T[(k8 + j) * 257 + n];
          u32x4 w; w.x = cvt_pk_bf16(f[0], f[1]); w.y = cvt_pk_bf16(f[2], f[3]); w.z = cvt_pk_bf16(f[4], f[5]); w.w = cvt_pk_bf16(f[6], f[7]);
          const int nn = n0 + n; const int drow = rm == 0 ? nn : ((nn >> 7) * 256 + (nn & 127) + (rm == 2 ? 128 : 0));
          *(u32x4*)(dst + (size_t)drow * ldd + k0 + k8) = w; }
    }
    base += ntiles;
}
__device__ __forceinline__ void build_ws(const int tid, const float* ws_in, bf16_t* dst) {
    const int total = 16 * 256 * 32;
    for (int p = blockIdx.x * NTHREADS + tid; p < total; p += gridDim.x * NTHREADS) {
        const int lg = p / (256 * 32), t = (p / 32) % 256, s8 = (p % 32) * 8; float f[8];
#pragma unroll
        for (int j = 0; j < 8; ++j) { const int s = s8 + j; const bool keep = ((t >> 7) == (s >> 7)) && ((s & 127) <= (t & 127));
            f[j] = keep ? ws_in[(size_t)lg * 16384 + (t & 127) * 128 + (s & 127)] : 0.f; }
        u32x4 w; w.x = cvt_pk_bf16(f[0], f[1]); w.y = cvt_pk_bf16(f[2], f[3]); w.z = cvt_pk_bf16(f[4], f[5]); w.w = cvt_pk_bf16(f[6], f[7]);
        *(u32x4*)(dst + (size_t)lg * 65536 + t * 256 + s8) = w;
    }
}
__device__ __forceinline__ void norm_pass(const int tid, const float* xin, const bf16_t* mo, const float* gpost, const float* gpre, float* xout, bf16_t* hout) {
    const int lane = tid & 63, wid = tid >> 6;
    f32x4 gp[4], gq[4];
#pragma unroll
    for (int i = 0; i < 4; ++i) { gp[i] = mo ? *(const f32x4*)(gpost + i * 256 + lane * 4) : (f32x4){0.f, 0.f, 0.f, 0.f}; gq[i] = hout ? *(const f32x4*)(gpre + i * 256 + lane * 4) : (f32x4){0.f, 0.f, 0.f, 0.f}; }
    for (int row = blockIdx.x * 8 + wid; row < MTOK; row += gridDim.x * 8) {
        f32x4 x[4];
#pragma unroll
        for (int i = 0; i < 4; ++i) x[i] = *(const f32x4*)(xin + (size_t)row * DM + i * 256 + lane * 4);
        if (mo) {
            f32x4 mv[4]; float q = 0.f;
#pragma unroll
            for (int i = 0; i < 4; ++i) { const u32x2 w = *(const u32x2*)(mo + (size_t)row * DM + i * 256 + lane * 4); mv[i] = (f32x4){bf_lo(w.x), bf_hi(w.x), bf_lo(w.y), bf_hi(w.y)};
                q += (mv[i][0] * mv[i][0] + mv[i][1] * mv[i][1]) + (mv[i][2] * mv[i][2] + mv[i][3] * mv[i][3]); }
#pragma unroll
            for (int o = 32; o >= 1; o >>= 1) q += __shfl_xor(q, o);
            const float rs = 1.0f / sqrtf(q * (1.0f / DM) + EPS);
#pragma unroll
            for (int i = 0; i < 4; ++i) x[i] += mv[i] * rs * gp[i];
        }
        if (xout) {
#pragma unroll
            for (int i = 0; i < 4; ++i) *(f32x4*)(xout + (size_t)row * DM + i * 256 + lane * 4) = x[i];
        }
        if (hout) {
            float q = 0.f;
#pragma unroll
            for (int i = 0; i < 4; ++i) q += (x[i][0] * x[i][0] + x[i][1] * x[i][1]) + (x[i][2] * x[i][2] + x[i][3] * x[i][3]);
#pragma unroll
            for (int o = 32; o >= 1; o >>= 1) q += __shfl_xor(q, o);
            const float rs = 1.0f / sqrtf(q * (1.0f / DM) + EPS);
#pragma unroll
            for (int i = 0; i < 4; ++i) { const f32x4 h = x[i] * rs * gq[i]; u32x2 w; w.x = cvt_pk_bf16(h[0], h[1]); w.y = cvt_pk_bf16(h[2], h[3]);
                *(u32x2*)(hout + (size_t)row * DM + i * 256 + lane * 4) = w; }
        }
    }
}
__device__ __forceinline__ void lnt_pass(LAS unsigned char* lds, const int tid, const bf16_t* V, const float* stats, const float* lg, const float* lb, bf16_t* VnT) {
    LAS unsigned* T = (LAS unsigned*)lds;
    LAS f32x2* MR = (LAS f32x2*)(lds + 32768);
    for (int strip = blockIdx.x; strip < MTOK / 128; strip += gridDim.x) {
        const int t0 = strip * 128;
        __syncthreads();
        if (tid < 128) { const f32x4* sp = (const f32x4*)(stats + (size_t)(t0 + tid) * 64); float s = 0.f, q = 0.f;
#pragma unroll
            for (int i = 0; i < 16; ++i) { const f32x4 v = sp[i]; s += v[0] + v[2]; q += v[1] + v[3]; }
            const float mean = s * (1.0f / AW); const float var = fmaxf(q * (1.0f / AW) - mean * mean, 0.f);
            MR[tid] = (f32x2){mean, 1.0f / sqrtf(var + EPS)}; }
        __syncthreads();
        for (int ct = 0; ct < AW / 128; ++ct) {
            const int c0 = ct * 128;
#pragma unroll
            for (int i = 0; i < 2; ++i) { const int o = tid + i * 512, c8i = o & 15, rp = o >> 4; const int c = c0 + c8i * 8;
                const u32x4 r0 = *(const u32x4*)(V + (size_t)(t0 + 2 * rp) * AW + c), r1 = *(const u32x4*)(V + (size_t)(t0 + 2 * rp + 1) * AW + c);
                const f32x4 g0 = *(const f32x4*)(lg + c), g1 = *(const f32x4*)(lg + c + 4), b0 = *(const f32x4*)(lb + c), b1 = *(const f32x4*)(lb + c + 4);
                const f32x2 m0 = MR[2 * rp], m1 = MR[2 * rp + 1];
                const unsigned ra[4] = {r0.x, r0.y, r0.z, r0.w}, rb[4] = {r1.x, r1.y, r1.z, r1.w};
                const float gg[8] = {g0[0], g0[1], g0[2], g0[3], g1[0], g1[1], g1[2], g1[3]}, bb[8] = {b0[0], b0[1], b0[2], b0[3], b1[0], b1[1], b1[2], b1[3]};
                const int pcol = (rp + 4 * c8i) & 63;
#pragma unroll
                for (int j = 0; j < 4; ++j) {
                    const float a_lo = (bf_lo(ra[j]) - m0.x) * m0.y * gg[2 * j] + bb[2 * j], a_hi = (bf_hi(ra[j]) - m0.x) * m0.y * gg[2 * j + 1] + bb[2 * j + 1];
                    const float b_lo = (bf_lo(rb[j]) - m1.x) * m1.y * gg[2 * j] + bb[2 * j], b_hi = (bf_hi(rb[j]) - m1.x) * m1.y * gg[2 * j + 1] + bb[2 * j + 1];
                    T[(c8i * 8 + 2 * j) * 64 + pcol] = cvt_pk_bf16(a_lo, b_lo);
                    T[(c8i * 8 + 2 * j + 1) * 64 + pcol] = cvt_pk_bf16(a_hi, b_hi);
                } }
            __syncthreads();
#pragma unroll
            for (int i = 0; i < 4; ++i) { const int o = tid + i * 512, cl = o >> 4, q = o & 15; const int ph = (4 * q + 4 * (cl >> 3)) & 63;
                const u32x4 w = *(const LAS u32x4*)(T + cl * 64 + ph);
                *(u32x4*)(VnT + (size_t)(c0 + cl) * MTOK + t0 + 8 * q) = w; }
            __syncthreads();
        }
    }
}
__device__ __forceinline__ void pool_pass(const int tid, const float* P, bf16_t* O) {
    const size_t total = (size_t)MTOK * 256;
    for (size_t idx = (size_t)blockIdx.x * NTHREADS + tid; idx < total; idx += (size_t)gridDim.x * NTHREADS) {
        const int t = (int)(idx >> 8), c4 = (int)(idx & 255) * 4; const int win = 2 << (c4 >> 8); const int tin = t & (SEQ - 1); const int cnt = (tin + 1) < win ? (tin + 1) : win;
        const float* p = P + (size_t)t * DM + c4; const f32x4 self = *(const f32x4*)p; f32x4 s = self;
        for (int j = 1; j < cnt; ++j) s += *(const f32x4*)(p - (size_t)j * DM);
        const float inv = 1.0f / (float)cnt; const f32x4 r = s * inv - self;
        u32x2 w; w.x = cvt_pk_bf16(r[0], r[1]); w.y = cvt_pk_bf16(r[2], r[3]); *(u32x2*)(O + (size_t)t * DM + c4) = w;
    }
}

#define XB_TMO      128
#define XB_XCNT(j)  (256  + 64 * (j))
#define XB_XSUB(j)  (1280 + 64 * (j))
#define XB_XGEN(j)  (2304 + 64 * (j))
#define XB_TOP      3328
#define XB_TOPGEN   3392
#define XCD_BAR_WORDS 3456
#define XB_SPIN_CAP (1u << 18)
__device__ __forceinline__ unsigned xb_ld(unsigned* p)              { return __hip_atomic_load(p, __ATOMIC_RELAXED, __HIP_MEMORY_SCOPE_AGENT); }
__device__ __forceinline__ unsigned xb_add(unsigned* p, unsigned v) { return __hip_atomic_fetch_add(p, v, __ATOMIC_RELAXED, __HIP_MEMORY_SCOPE_AGENT); }
__device__ __forceinline__ unsigned xb_xcc_id() { return (unsigned)__builtin_amdgcn_s_getreg((3 << 11) | 20) & 0xFu; }
#define XB_SPIN(cond, bar) do { unsigned _sp = 0; while (cond) { __builtin_amdgcn_s_sleep(1); \
    if ((++_sp & 255u) == 0u) { if (xb_ld(&(bar)[XB_TMO])) break; if (_sp > XB_SPIN_CAP) { atomicAdd(&(bar)[XB_TMO], 1u); break; } } } } while (0)
struct XcdBarrier { unsigned* bar; unsigned x; volatile LAS unsigned* st; };
__device__ __forceinline__ XcdBarrier xcd_barrier_post(unsigned* bar, volatile LAS unsigned* st) {
    XcdBarrier b; b.bar = bar; b.x = xb_xcc_id(); b.st = st;
    if (threadIdx.x == 0) (void)xb_add(&bar[XB_XCNT(b.x)], 1u);
    return b;
}
__device__ __forceinline__ void xcd_barrier_complete(unsigned* bar, unsigned x, unsigned& nloc, unsigned& nx) {
    const unsigned G = gridDim.x * gridDim.y * gridDim.z;
    unsigned sum, cnt, mine, sp = 0u;
    for (;;) {
        sum = 0u; cnt = 0u; mine = 0u;
#pragma unroll
        for (unsigned j = 0; j < 16; ++j) { const unsigned c = xb_ld(&bar[XB_XCNT(j)]); sum += c; cnt += (c > 0u) ? 1u : 0u; mine = (j == x) ? c : mine; }
        if (sum == G) break;
        __builtin_amdgcn_s_sleep(1);
        if ((++sp & 255u) == 0u) { if (xb_ld(&bar[XB_TMO])) break; if (sp > XB_SPIN_CAP) { atomicAdd(&bar[XB_TMO], 1u); break; } }
    }
    nloc = mine > 0u ? mine : 1u; nx = cnt > 0u ? cnt : 1u;
}
__device__ __forceinline__ void xcd_barrier(const XcdBarrier& b) {
    asm volatile("s_waitcnt vmcnt(0)" ::: "memory");
    __syncthreads();
    if (threadIdx.x == 0) {
        unsigned* bar = b.bar;
        __builtin_amdgcn_s_waitcnt(0);
        unsigned nloc = b.st[0], nx = b.st[1];
        if (nloc == 0u) { xcd_barrier_complete(bar, b.x, nloc, nx); b.st[0] = nloc; b.st[1] = nx; }
        const unsigned old = xb_add(&bar[XB_XSUB(b.x)], 1u);
        const unsigned gen = old / nloc;
        if (old + 1u == (gen + 1u) * nloc) {
            __builtin_amdgcn_fence(__ATOMIC_RELEASE, "agent");
            asm volatile("s_waitcnt vmcnt(0)" ::: "memory");
            const unsigned og = xb_add(&bar[XB_TOP], 1u);
            const unsigned tg = og / nx;
            if (og + 1u == (tg + 1u) * nx) xb_add(&bar[XB_TOPGEN], 1u);
            else XB_SPIN(xb_ld(&bar[XB_TOPGEN]) == tg, bar);
            __builtin_amdgcn_fence(__ATOMIC_ACQUIRE, "agent");
            xb_add(&bar[XB_XGEN(b.x)], 1u);
            asm volatile("s_waitcnt vmcnt(0)" ::: "memory");
        } else {
            XB_SPIN(xb_ld(&bar[XB_XGEN(b.x)]) == gen, bar);
            __builtin_amdgcn_fence(__ATOMIC_ACQUIRE, "agent");
            asm volatile("s_waitcnt vmcnt(0)" ::: "memory");
        }
    }
    __syncthreads();
}

struct Args { const float* in[18]; float* out; unsigned char* ws; int ph_lo, ph_hi; };
constexpr int N_PHASES = 1 + DEPTH * 8;

__global__ void __launch_bounds__(NTHREADS, 2) fwd_mega(Args a) {
    extern __shared__ __attribute__((aligned(16))) unsigned char lds_raw[];
    LAS unsigned char* lds = (LAS unsigned char*)lds_raw;
    cg::grid_group grid = cg::this_grid();
    unsigned char* ws = a.ws;
    const float* x_in = a.in[0];
    bf16_t* U = (bf16_t*)(ws + WS_R1); float* P = (float*)(ws + WS_R1); bf16_t* ACT = (bf16_t*)(ws + WS_R1);
    bf16_t* V = (bf16_t*)(ws + WS_R2); bf16_t* GT = (bf16_t*)(ws + WS_R2); bf16_t* POOL = (bf16_t*)(ws + WS_R2); bf16_t* MIX = (bf16_t*)(ws + WS_R2 + 64 * MiB);
    bf16_t* H = (bf16_t*)(ws + WS_R3); bf16_t* MO = (bf16_t*)(ws + WS_R3 + 64 * MiB); bf16_t* VNT = (bf16_t*)(ws + WS_R3);
    float* STATS = (float*)(ws + WS_STATS);
    const int G = gridDim.x, bid = blockIdx.x;
    volatile LAS unsigned* bst = (volatile LAS unsigned*)(lds + STAGE_BYTES);
    if (threadIdx.x < 16) bst[threadIdx.x] = 0u;
    __syncthreads();
    XcdBarrier bar; bar.bar = (unsigned*)(ws + WS_BAR); bar.x = 0; bar.st = bst;
    if (a.ph_hi - a.ph_lo > 1) bar = xcd_barrier_post((unsigned*)(ws + WS_BAR), bst);

    for (int ph = a.ph_lo; ph < a.ph_hi; ++ph) {
        int tid = threadIdx.x; asm volatile("" : "+v"(tid));
        if (ph == 0 && (PHMASK & 1)) {
            int base = 0;
            for (int j = 0; j < 2; ++j) {
                tr_cvt(lds, tid, a.in[1] + (size_t)j * DM * 4096, DM, 4096, 4096, (bf16_t*)(ws + WS_AWIN) + (size_t)j * 4096 * DM, DM, 0, base);
                tr_cvt(lds, tid, a.in[6] + (size_t)j * AW * DM, AW, DM, DM, (bf16_t*)(ws + WS_AWOUT) + (size_t)j * DM * AW, AW, 0, base);
                tr_cvt(lds, tid, a.in[7] + (size_t)j * DM * DM, DM, DM, DM, (bf16_t*)(ws + WS_BWIN) + (size_t)j * DM * DM, DM, 0, base);
                for (int g = 0; g < 4; ++g) tr_cvt(lds, tid, a.in[8] + (size_t)(j * 4 + g) * 65536, 256, 256, 256, (bf16_t*)(ws + WS_BWGRP) + (size_t)(j * 4 + g) * 65536, 256, 0, base);
                tr_cvt(lds, tid, a.in[10] + (size_t)j * DM * DM, DM, DM, DM, (bf16_t*)(ws + WS_BWOUT) + (size_t)j * DM * DM, DM, 0, base);
            }
            for (int i = 0; i < DEPTH; ++i) {
                tr_cvt(lds, tid, a.in[15] + (size_t)i * DM * DFF, DM, DFF, DFF, (bf16_t*)(ws + WS_FGU) + (size_t)i * 2 * DFF * DM, DM, 1, base);
                tr_cvt(lds, tid, a.in[16] + (size_t)i * DM * DFF, DM, DFF, DFF, (bf16_t*)(ws + WS_FGU) + (size_t)i * 2 * DFF * DM, DM, 2, base);
                tr_cvt(lds, tid, a.in[17] + (size_t)i * DFF * DM, DFF, DM, DM, (bf16_t*)(ws + WS_FDN) + (size_t)i * DM * DFF, DFF, 0, base);
            }
            build_ws(tid, a.in[4], (bf16_t*)(ws + WS_AWS));
            norm_pass(tid, x_in, nullptr, nullptr, a.in[11], nullptr, H);
        } else {
            const int li = (ph - 1) >> 3, st = (ph - 1) & 7, j = li >> 1; const bool isB = li & 1;
            if (st == 0) {
                if (!isB && (PHMASK & 2)) {
                    Gemm g{H, (const bf16_t*)(ws + WS_AWIN) + (size_t)j * 4096 * DM, DM, DM, DM, (long)BM * DM, 0, 0, (long)BM * DM};
                    StaticOrder S; S.init(MTOK / BM, 4096 / BM, G, bid); EpiGeluUV E{U, V, STATS};
                    gemm_phase(lds, tid, g, S, E);
                } else if (isB && (PHMASK & 4)) {
                    Gemm g{H, (const bf16_t*)(ws + WS_BWIN) + (size_t)j * DM * DM, DM, DM, DM, (long)BM * DM, 0, 0, (long)BM * DM};
                    StaticOrder S; S.init(MTOK / BM, DM / BM, G, bid); EpiF32 E{P, DM};
                    gemm_phase(lds, tid, g, S, E);
                }
            } else if (st == 1) {
                if (!isB && (PHMASK & 8)) lnt_pass(lds, tid, V, STATS, a.in[2] + j * AW, a.in[3] + j * AW, VNT);
                else if (isB && (PHMASK & 16)) pool_pass(tid, P, POOL);
            } else if (st == 2) {
                if (!isB && (PHMASK & 32)) {
                    Gemm g{(const bf16_t*)(ws + WS_AWS) + (size_t)j * 8 * 65536, VNT, 256, MTOK, 256, 0, 65536, 256, (long)256 * MTOK};
                    StaticOrder S; S.init(MTOK / BM, 8, G, bid); EpiGate E{U, GT, a.in[5] + j * 8 * 128};
                    gemm_phase(lds, tid, g, S, E);
                } else if (isB && (PHMASK & 64)) {
                    Gemm g{POOL, (const bf16_t*)(ws + WS_BWGRP) + (size_t)j * 4 * 65536, DM, 256, 256, (long)BM * DM, 256, 0, 65536};
                    StaticOrder S; S.init(MTOK / BM, 4, G, bid); EpiBf16S E{MIX, DM, a.in[9] + j * DM};
                    gemm_phase(lds, tid, g, S, E);
                }
            } else if ((st == 3 || st == 6) && (PHMASK & 128)) {
                Gemm g;
                if (st == 6) g = Gemm{ACT, (const bf16_t*)(ws + WS_FDN) + (size_t)li * DM * DFF, DFF, DFF, DFF, (long)BM * DFF, 0, 0, (long)BM * DFF};
                else if (!isB) g = Gemm{GT, (const bf16_t*)(ws + WS_AWOUT) + (size_t)j * DM * AW, AW, AW, AW, (long)BM * AW, 0, 0, (long)BM * AW};
                else g = Gemm{MIX, (const bf16_t*)(ws + WS_BWOUT) + (size_t)j * DM * DM, DM, DM, DM, (long)BM * DM, 0, 0, (long)BM * DM};
                StaticOrder S; S.init(MTOK / BM, DM / BM, G, bid); EpiBf16S E{MO, DM, nullptr};
                gemm_phase(lds, tid, g, S, E);
            } else if (st == 4 && (PHMASK & 256)) {
                norm_pass(tid, li == 0 ? x_in : a.out, MO, a.in[12] + li * DM, a.in[13] + li * DM, a.out, H);
            } else if (st == 5 && (PHMASK & 512)) {
                Gemm g{H, (const bf16_t*)(ws + WS_FGU) + (size_t)li * 2 * DFF * DM, DM, DM, DM, (long)BM * DM, 0, 0, (long)BM * DM};
                StaticOrder S; S.init(MTOK / BM, 2 * DFF / BM, G, bid); EpiSwiGLU E{ACT};
                gemm_phase(lds, tid, g, S, E);
            } else if (st == 7 && (PHMASK & 1024)) {
                const bool lastl = (li == DEPTH - 1);
                norm_pass(tid, a.out, MO, a.in[14] + li * DM, lastl ? a.in[11] : a.in[11] + (li + 1) * DM, a.out, lastl ? nullptr : H);
            }
        }
        if (ph + 1 < a.ph_hi) { if (ph == 0) grid.sync(); else xcd_barrier(bar); }
    }
}

extern "C" void kernel_launch(void* const* d_in, const int* in_sizes, int n_in, void* d_out, int out_size, void* d_ws, size_t ws_size, hipStream_t stream) {
    static int grid = 0;
    if (grid == 0) {
        if (n_in != 18 || ws_size < WS_END) { fprintf(stderr, "kernel_launch: unexpected n_in %d / ws %zu\n", n_in, ws_size); grid = -1; return; }
        int dev = 0, cus = 0, per_cu = 0;
        hipGetDevice(&dev); hipDeviceGetAttribute(&cus, hipDeviceAttributeMultiprocessorCount, dev);
        if (hipFuncSetAttribute((const void*)fwd_mega, hipFuncAttributeMaxDynamicSharedMemorySize, LDS_BYTES) != hipSuccess) { fprintf(stderr, "kernel_launch: hipFuncSetAttribute failed\n"); grid = -1; return; }
        if (hipOccupancyMaxActiveBlocksPerMultiprocessor(&per_cu, (const void*)fwd_mega, NTHREADS, LDS_BYTES) != hipSuccess || per_cu < 1) { fprintf(stderr, "kernel_launch: occupancy query says %d\n", per_cu); per_cu = 1; }
        (void)hipGetLastError();
        grid = cus;
    }
    if (grid < 0) return;
    Args a{};
    for (int i = 0; i < 18; ++i) a.in[i] = (const float*)d_in[i];
    a.out = (float*)d_out; a.ws = (unsigned char*)d_ws;
#if N_LAUNCH_MODE == 1
    for (int ph = 0; ph < N_PHASES; ++ph) { a.ph_lo = ph; a.ph_hi = ph + 1; hipLaunchKernelGGL(fwd_mega, dim3(grid), dim3(NTHREADS), LDS_BYTES, stream, a); }
#else
    a.ph_lo = 0; a.ph_hi = N_PHASES;
    if (hipMemsetAsync((char*)d_ws + WS_BAR, 0, XCD_BAR_WORDS * sizeof(unsigned), stream) != hipSuccess) { fprintf(stderr, "memset failed\n"); return; }
    void* args[] = {&a};
    hipError_t e = hipLaunchCooperativeKernel((const void*)fwd_mega, dim3(grid), dim3(NTHREADS), args, LDS_BYTES, stream);
    if (e != hipSuccess) fprintf(stderr, "cooperative launch failed: %s (grid %d)\n", hipGetErrorString(e), grid);
#endif
}
```
